# Optimizing an MI355X kernel written in HIP

```python
import math
import jax, jax.numpy as jnp
from jax import lax
import numpy as np

D_MODEL = 4096
BATCH = 2
SEQ = 8192
DEPTH = 2

BRANCH_W = D_MODEL // 2
N_BRANCH = 3
RET_HEAD_DIM = 256
RET_W = BRANCH_W
RET_HEADS = RET_W // RET_HEAD_DIM
RET_CHUNK = 128
DSA_HEAD_DIM = 128
DSA_W = BRANCH_W
DSA_HEADS = DSA_W // DSA_HEAD_DIM
DSA_KV_HEADS = 4
DSA_KV_W = DSA_KV_HEADS * DSA_HEAD_DIM
IDX_HEADS = 32
IDX_DIM = 128
TOPK_MAX = 256
Q_BLOCK = 128
GM_W = BRANCH_W
GM_GROUPS = 16
GM_GROUP_DIM = GM_W // GM_GROUPS
GM_CHUNK = 128

ROPE_THETA = 10000.0
EPS = 1e-6

IN_SPLITS = (RET_W, RET_W, RET_W, RET_W,
             DSA_W, DSA_KV_W, DSA_KV_W,
             IDX_HEADS * IDX_DIM, IDX_DIM, IDX_HEADS,
             DSA_W,
             GM_W, GM_W, GM_W,
             N_BRANCH * D_MODEL)
N_IN = sum(IN_SPLITS)

kernel_name = "hybrid_retention_dsa_gmlp_gated"


def rms_norm(x, g):
    xf = x.astype(jnp.float32)
    y = xf * lax.rsqrt(jnp.mean(xf * xf, axis=-1, keepdims=True) + EPS)
    return (y * g.astype(jnp.float32)).astype(x.dtype)


def layer_norm(x, g):
    xf = x.astype(jnp.float32)
    mu = jnp.mean(xf, axis=-1, keepdims=True)
    xc = xf - mu
    y = xc * lax.rsqrt(jnp.mean(xc * xc, axis=-1, keepdims=True) + EPS)
    return (y * g.astype(jnp.float32)).astype(x.dtype)


def rope(x, pos):
    d = x.shape[-1]
    half = d // 2
    inv = 1.0 / (ROPE_THETA ** (jnp.arange(half, dtype=jnp.float32) * 2.0 / d))
    ang = pos.astype(jnp.float32)[..., None] * inv
    cos = jnp.cos(ang)[:, :, None, :]
    sin = jnp.sin(ang)[:, :, None, :]
    x1 = x[..., :half].astype(jnp.float32)
    x2 = x[..., half:].astype(jnp.float32)
    return jnp.concatenate([x1 * cos - x2 * sin, x2 * cos + x1 * sin], axis=-1).astype(x.dtype)


def retention(q, k, v, pos):
    B, S, H, dk = q.shape
    dv = v.shape[-1]
    C = RET_CHUNK
    N = S // C
    q = rope(q, pos).astype(jnp.float32)
    k = rope(k, pos).astype(jnp.float32) * (dk ** -0.5)
    v = v.astype(jnp.float32)
    log_g = jnp.log(1.0 - jnp.power(2.0, -5.0 - jnp.arange(H, dtype=jnp.float32)))
    n = jnp.arange(C, dtype=jnp.float32)
    diff = n[:, None] - n[None, :]
    decay = jnp.where(diff >= 0, jnp.exp(log_g[:, None, None] * jnp.maximum(diff, 0.0)), 0.0)
    xi = jnp.exp(log_g[:, None] * (n + 1.0))
    zeta = jnp.exp(log_g[:, None] * (C - 1.0 - n))
    chunk_decay = jnp.exp(log_g * C)

    def to_chunks(a):
        return a.reshape(B, N, C, H, a.shape[-1]).transpose(1, 0, 3, 2, 4)

    def step(R, qkv):
        qc, kc, vc = qkv
        inner = jnp.einsum('bhnm,bhme->bhne', jnp.einsum('bhnd,bhmd->bhnm', qc, kc) * decay, vc)
        cross = jnp.einsum('bhnd,bhde->bhne', qc * xi[..., None], R)
        R = R * chunk_decay[:, None, None] + jnp.einsum('bhmd,bhme->bhde', kc * zeta[..., None], vc)
        return R, inner + cross

    R0 = jnp.zeros((B, H, dk, dv), jnp.float32)
    _, out = lax.scan(step, R0, (to_chunks(q), to_chunks(k), to_chunks(v)))
    return out.transpose(1, 0, 3, 2, 4).reshape(B, S, H, dv)


def dsa_attention(q, k, v, q_idx, k_idx, w_idx, topk):
    B, S, H, dh = q.shape
    KVH = k.shape[2]
    G = H // KVH
    nb = S // Q_BLOCK
    key_pos = jnp.arange(S)

    def block(args):
        qb, qib, wb, t0 = args
        t_pos = t0 + jnp.arange(Q_BLOCK)
        s = jnp.einsum('bthd,bsd->bths', qib, k_idx).astype(jnp.float32) * (IDX_DIM ** -0.5)
        w = wb.astype(jnp.float32) * (IDX_HEADS ** -0.5)
        score = jnp.einsum('bth,bths->bts', w, jax.nn.relu(s))
        causal = key_pos[None, :] <= t_pos[:, None]
        score = jnp.where(causal[None], score, -jnp.inf)
        _, sel = lax.top_k(score, topk)
        k_sel = jax.vmap(lambda kb, ib: kb[ib])(k, sel)
        v_sel = jax.vmap(lambda vb, ib: vb[ib])(v, sel)
        valid = sel <= t_pos[None, :, None]
        qg = qb.reshape(B, Q_BLOCK, KVH, G, dh)
        logits = jnp.einsum('btkgd,btskd->btkgs', qg, k_sel).astype(jnp.float32) * (dh ** -0.5)
        logits = jnp.where(valid[:, :, None, None, :], logits, -jnp.inf)
        p = jax.nn.softmax(logits, axis=-1)
        o = jnp.einsum('btkgs,btskd->btkgd', p.astype(v.dtype), v_sel)
        return o.reshape(B, Q_BLOCK, H, dh)

    def to_blocks(a):
        a = a.reshape((B, nb, Q_BLOCK) + a.shape[2:])
        return jnp.moveaxis(a, 1, 0)

    t0s = jnp.arange(nb, dtype=jnp.int32) * Q_BLOCK
    out = lax.map(block, (to_blocks(q), to_blocks(q_idx), to_blocks(w_idx), t0s))
    return jnp.moveaxis(out, 0, 1).reshape(B, S, H, dh)


def spatial_gating(u, v, g_norm, w_s, b_s):
    B, S, _ = u.shape
    C = GM_CHUNK
    N = S // C
    v = layer_norm(v, g_norm)
    vc = v.reshape(B, N, C, GM_GROUPS, GM_GROUP_DIM)
    uc = u.reshape(B, N, C, GM_GROUPS, GM_GROUP_DIM)
    w_masked = w_s * jnp.tril(jnp.ones((C, C), w_s.dtype))[None]
    mixed = jnp.einsum('gts,bnsgc->bntgc', w_masked, vc) + b_s.T[None, None, :, :, None]
    return (uc * mixed).reshape(B, S, GM_W)


def setup_inputs(seed: int = 0) -> dict:
    key = jax.random.key(seed)
    ks = jax.random.split(key, 12)
    x = jax.random.normal(ks[0], (BATCH, SEQ, D_MODEL), jnp.float32)
    offset = jax.random.randint(ks[1], (BATCH, 1), 0, 1024, dtype=jnp.int32)
    positions = (offset + jnp.arange(SEQ, dtype=jnp.int32)[None, :]).astype(jnp.int32)
    norm_gain = 1.0 + 0.02 * jax.random.normal(ks[2], (DEPTH, D_MODEL), jnp.float32)
    w_in = jax.random.normal(ks[3], (DEPTH, D_MODEL, N_IN), jnp.float32) * (D_MODEL ** -0.5)
    ret_norm_gain = 1.0 + 0.02 * jax.random.normal(ks[4], (DEPTH, RET_W), jnp.float32)
    q_norm_gain = 1.0 + 0.02 * jax.random.normal(ks[5], (DEPTH, DSA_HEAD_DIM), jnp.float32)
    k_norm_gain = 1.0 + 0.02 * jax.random.normal(ks[6], (DEPTH, DSA_HEAD_DIM), jnp.float32)
    gm_norm_gain = 1.0 + 0.02 * jax.random.normal(ks[7], (DEPTH, GM_W), jnp.float32)
    w_spatial = jax.random.normal(ks[8], (DEPTH, GM_GROUPS, GM_CHUNK, GM_CHUNK), jnp.float32) * (GM_CHUNK ** -0.5)
    b_spatial = 1.0 + 0.02 * jax.random.normal(ks[9], (DEPTH, GM_GROUPS, GM_CHUNK), jnp.float32)
    w_branch = jax.random.normal(ks[10], (DEPTH, N_BRANCH, BRANCH_W, D_MODEL), jnp.float32) * (BRANCH_W ** -0.5)
    w_out = jax.random.normal(ks[11], (DEPTH, D_MODEL, D_MODEL), jnp.float32) * (D_MODEL ** -0.5)
    return {"x": x, "positions": positions, "norm_gain": norm_gain, "w_in": w_in,
            "ret_norm_gain": ret_norm_gain, "q_norm_gain": q_norm_gain, "k_norm_gain": k_norm_gain,
            "gm_norm_gain": gm_norm_gain, "w_spatial": w_spatial, "b_spatial": b_spatial,
            "w_branch": w_branch, "w_out": w_out}


def reference(x, positions, norm_gain, w_in, ret_norm_gain, q_norm_gain, k_norm_gain,
              gm_norm_gain, w_spatial, b_spatial, w_branch, w_out):
    B, S, _ = x.shape
    topk = min(TOPK_MAX, S // 4)
    split_points = np.cumsum(IN_SPLITS)[:-1].tolist()
    for l in range(DEPTH):
        xn = rms_norm(x, norm_gain[l])
        h = jnp.einsum('bsd,dn->bsn', xn, w_in[l])
        (rq, rk, rv, rg, dq, dk, dv, iq, ik, iw, dg, gu, gv, gg, mg) = jnp.split(h, split_points, axis=-1)

        ret = retention(rq.reshape(B, S, RET_HEADS, RET_HEAD_DIM),
                        rk.reshape(B, S, RET_HEADS, RET_HEAD_DIM),
                        rv.reshape(B, S, RET_HEADS, RET_HEAD_DIM), positions)
        ret = layer_norm(ret, ret_norm_gain[l].reshape(RET_HEADS, RET_HEAD_DIM)).astype(x.dtype)
        y_ret = jax.nn.silu(rg) * ret.reshape(B, S, RET_W)

        q = rope(rms_norm(dq.reshape(B, S, DSA_HEADS, DSA_HEAD_DIM), q_norm_gain[l]), positions)
        k = rope(rms_norm(dk.reshape(B, S, DSA_KV_HEADS, DSA_HEAD_DIM), k_norm_gain[l]), positions)
        v = dv.reshape(B, S, DSA_KV_HEADS, DSA_HEAD_DIM)
        qi = rope(iq.reshape(B, S, IDX_HEADS, IDX_DIM), positions)
        ki = rope(ik[:, :, None, :], positions)[:, :, 0]
        att = dsa_attention(q, k, v, qi, ki, iw, topk)
        y_dsa = jax.nn.silu(dg) * att.reshape(B, S, DSA_W)

        sg = spatial_gating(jax.nn.gelu(gu), jax.nn.gelu(gv), gm_norm_gain[l], w_spatial[l], b_spatial[l])
        y_gm = jax.nn.silu(gg) * sg

        gates = jax.nn.sigmoid(mg).reshape(B, S, N_BRANCH, D_MODEL)
        merged = (gates[:, :, 0] * jnp.einsum('bsw,wd->bsd', y_ret, w_branch[l, 0])
                  + gates[:, :, 1] * jnp.einsum('bsw,wd->bsd', y_dsa, w_branch[l, 1])
                  + gates[:, :, 2] * jnp.einsum('bsw,wd->bsd', y_gm, w_branch[l, 2]))
        x = x + jnp.einsum('bsd,de->bse', merged, w_out[l])
    return x
```

```cpp
#include <hip/hip_runtime.h>
#include <cstdio>
#include <cstdint>
#ifndef PG8_WGM
#define PG8_WGM 8
#endif
namespace pg8 {
#define PG8_LAS __attribute__((address_space(3)))
typedef unsigned short bf16_t;
typedef short bf16x8 __attribute__((ext_vector_type(8)));
typedef float f32x4 __attribute__((ext_vector_type(4)));
typedef unsigned u32x4 __attribute__((ext_vector_type(4)));
constexpr int BM = 256, BK = 64, HALF = 128, HTB = HALF * BK * 2  , STAGE_BYTES = 8 * HTB, NXCD = 8, WGM = PG8_WGM;

__host__ __device__ __forceinline__ int lds_byte(int r, int c) { const int st = (r >> 4) * 2 + (c >> 5), rr = r & 15, cc = c & 31, ob = rr * 64 + cc * 2; return st * 1024 + (ob ^ (((ob >> 9) & 1) << 5)); }
__host__ __device__ __forceinline__ void stage_rc(int b, int& R, int& C) { const int st = b / 1024, sb = b % 1024, swz = sb ^ (((sb >> 9) & 1) << 5); R = (st >> 1) * 16 + swz / 64; C = (st & 1) * 32 + (swz % 64) / 2; }
__host__ __device__ __forceinline__ int perm32(int rho) { const int n = rho >> 4, i = rho & 15; return 8 * (i >> 2) + 4 * n + (i & 3); }

struct Unit { int pm, pn; };
struct Gemm { const bf16_t* A; const bf16_t* Bt; int M, N, K; int ld = 0; };

struct StaticOrder {
    int nM, nN, nwg, G, c, limit;
    __host__ __device__ void init(int M, int N, int G_, int c_) { nM = M / BM; nN = N / BM; nwg = nM * nN; G = G_; c = c_; limit = nwg; }
    __host__ __device__ void unit_of(int L, Unit& u) const {
        int wgid = L; { const int q = nwg / NXCD, r = nwg % NXCD, xcd = wgid % NXCD, off = wgid / NXCD; wgid = (xcd < r ? xcd * (q + 1) : r * (q + 1) + (xcd - r) * q) + off; }
        const int nig = WGM * nN, gid = wgid / nig, fm = gid * WGM, gsz = (nM - fm) < WGM ? (nM - fm) : WGM;
        u.pm = fm + ((wgid % nig) % gsz); u.pn = (wgid % nig) / gsz; }
    __host__ __device__ bool next(int i, Unit& u) const {
        const long L = (long)i * G + c; if (L >= limit) return false;
        int wgid = (int)L; { const int q = nwg / NXCD, r = nwg % NXCD, xcd = wgid % NXCD, off = wgid / NXCD; wgid = (xcd < r ? xcd * (q + 1) : r * (q + 1) + (xcd - r) * q) + off; }
        const int nig = WGM * nN, gid = wgid / nig, fm = gid * WGM, gsz = (nM - fm) < WGM ? (nM - fm) : WGM;
        u.pm = fm + ((wgid % nig) % gsz); u.pn = (wgid % nig) / gsz; return true;
    }
    __device__ __forceinline__ void a_ready(const Unit&) const {}
    __device__ __forceinline__ void done(const Unit&) const {}
};

struct SplitOrder {
    StaticOrder base; int first, c;
    __device__ __forceinline__ bool next(int i, Unit& u) const { if (i > 0) return false; base.unit_of(first + (c >> 2), u); return true; }
    __device__ __forceinline__ void a_ready(const Unit&) const {}
    __device__ __forceinline__ void done(const Unit&) const {}
};
struct StaticOrderN {
    int nM, nN, nwg, G, c;
    __host__ __device__ void init(int M, int N, int G_, int c_) { nM = M / BM; nN = N / BM; nwg = nM * nN; G = G_; c = c_; }
    __host__ __device__ bool next(int i, Unit& u) const {
        const long L = (long)i * G + c; if (L >= nwg) return false;
        int wgid = (int)L; { const int q = nwg / NXCD, r = nwg % NXCD, xcd = wgid % NXCD, off = wgid / NXCD; wgid = (xcd < r ? xcd * (q + 1) : r * (q + 1) + (xcd - r) * q) + off; }
        const int nig = WGM * nM, gid = wgid / nig, fn = gid * WGM, gsz = (nN - fn) < WGM ? (nN - fn) : WGM;
        u.pn = fn + ((wgid % nig) % gsz); u.pm = (wgid % nig) / gsz; return true;
    }
    __device__ __forceinline__ void a_ready(const Unit&) const {}
    __device__ __forceinline__ void done(const Unit&) const {}
};

__device__ __forceinline__ unsigned cvt_pk_bf16(float lo, float hi) { unsigned r; asm volatile("v_cvt_pk_bf16_f32 %0, %1, %2" : "=v"(r) : "v"(lo), "v"(hi)); return r; }
typedef float f32x2 __attribute__((ext_vector_type(2)));
typedef int i32x4 __attribute__((ext_vector_type(4)));
template <int DT> __device__ __forceinline__ f32x4 mma16(const bf16x8 a, const bf16x8 b, const f32x4 c) {
    if constexpr (DT == 0) return __builtin_amdgcn_mfma_f32_16x16x32_bf16(a, b, c, 0, 0, 0);
    else return __builtin_bit_cast(f32x4, __builtin_amdgcn_mfma_i32_16x16x64_i8(__builtin_bit_cast(i32x4, a), __builtin_bit_cast(i32x4, b), __builtin_bit_cast(i32x4, c), 0, 0, 0));
}
__device__ __forceinline__ float act_apply(float x, int act) {
    float u = x;
    if (act == 2) u = 1.5957691216057308f * (x + 0.044715f * x * x * x);
    const float s = __builtin_amdgcn_rcpf(1.0f + __builtin_amdgcn_exp2f(-1.4426950408889634f * u));
    return act == 3 ? s : x * s;
}
__device__ __forceinline__ int act_of_tile(int pn) { return (pn >= 93) ? 3 : (pn >= 85) ? 1 : (pn >= 69) ? 2 : (pn >= 61) ? 1 : (pn >= 32) ? 0 : (pn >= 24) ? 1 : 0; }
struct EpiH {
    static constexpr bool PERM = true, AFTER_DRAIN = false;
    bf16_t* O; int ldc; int pn0 = 0;
    __device__ __forceinline__ void operator()(const f32x4 (&acc)[2][2][4][2], const Unit& u, int wr, int wc, int fr, int fq) const {
        const int act = act_of_tile(u.pn + pn0);
        const int row0 = u.pm * BM + wr * 64 + fr, col0 = (u.pn + pn0) * BM + wc * 32 + 8 * fq;
#pragma unroll
        for (int ai = 0; ai < 2; ++ai)
#pragma unroll
            for (int m = 0; m < 4; ++m) { bf16_t* rowp = O + (size_t)(row0 + ai * HALF + m * 16) * ldc + col0;
#pragma unroll
                for (int bj = 0; bj < 2; ++bj) { f32x4 v0 = acc[ai][bj][m][0], v1 = acc[ai][bj][m][1];
                    if (act != 0) {
#pragma unroll
                        for (int j = 0; j < 4; ++j) { v0[j] = act_apply(v0[j], act); v1[j] = act_apply(v1[j], act); } }
                    u32x4 w; w.x = cvt_pk_bf16(v0[0], v0[1]); w.y = cvt_pk_bf16(v0[2], v0[3]); w.z = cvt_pk_bf16(v1[0], v1[1]); w.w = cvt_pk_bf16(v1[2], v1[3]);
                    *(u32x4*)(rowp + bj * HALF) = w; } }
    }
};
template <int MODE> struct EpiMerge {
    static constexpr bool PERM = true, AFTER_DRAIN = false;
    const bf16_t* gate; int ldg; bf16_t* Mb; int ldc; const float* rs; const float* cs;
    __device__ __forceinline__ void operator()(const f32x4 (&acc)[2][2][4][2], const Unit& u, int wr, int wc, int fr, int fq) const {
        const int row0 = u.pm * BM + wr * 64 + fr, col0 = u.pn * BM + wc * 32 + 8 * fq;
        f32x4 k0[2], k1[2];
#pragma unroll
        for (int bj = 0; bj < 2; ++bj) { k0[bj] = *(const f32x4*)(cs + col0 + bj * HALF); k1[bj] = *(const f32x4*)(cs + col0 + bj * HALF + 4); }
#pragma unroll
        for (int ab = 0; ab < 4; ++ab) { const int ai = ab >> 1, m0 = 2 * (ab & 1);
            u32x4 gq[2][2], pq[2][2]; float rq[2];
#pragma unroll
            for (int mm = 0; mm < 2; ++mm) { const int r = row0 + ai * HALF + (m0 + mm) * 16; rq[mm] = rs[r] * 1024.0f;
#pragma unroll
                for (int bj = 0; bj < 2; ++bj) { const int c = col0 + bj * HALF; gq[mm][bj] = *(const u32x4*)(gate + (size_t)r * ldg + c); if (MODE != 0) pq[mm][bj] = *(const u32x4*)(Mb + (size_t)r * ldc + c); } }
#pragma unroll
            for (int mm = 0; mm < 2; ++mm) { const int m = m0 + mm, r = row0 + ai * HALF + m * 16; const float rsc = rq[mm];
#pragma unroll
                for (int bj = 0; bj < 2; ++bj) { const int c = col0 + bj * HALF;
                    const u32x4 gw = gq[mm][bj];
                    f32x4 g0, g1;
                    g0[0] = __uint_as_float(gw.x << 16); g0[1] = __uint_as_float(gw.x & 0xffff0000u); g0[2] = __uint_as_float(gw.y << 16); g0[3] = __uint_as_float(gw.y & 0xffff0000u);
                    g1[0] = __uint_as_float(gw.z << 16); g1[1] = __uint_as_float(gw.z & 0xffff0000u); g1[2] = __uint_as_float(gw.w << 16); g1[3] = __uint_as_float(gw.w & 0xffff0000u);
#pragma unroll
                    for (int j = 0; j < 4; ++j) { g0[j] = act_apply(g0[j] * rsc * k0[bj][j], 3); g1[j] = act_apply(g1[j] * rsc * k1[bj][j], 3); }
                    f32x4 p0 = g0 * acc[ai][bj][m][0], p1 = g1 * acc[ai][bj][m][1];
                    bf16_t* mp = Mb + (size_t)r * ldc + c;
                    if (MODE != 0) { const u32x4 pw = pq[mm][bj];
                        p0[0] += __uint_as_float(pw.x << 16); p0[1] += __uint_as_float(pw.x & 0xffff0000u); p0[2] += __uint_as_float(pw.y << 16); p0[3] += __uint_as_float(pw.y & 0xffff0000u);
                        p1[0] += __uint_as_float(pw.z << 16); p1[1] += __uint_as_float(pw.z & 0xffff0000u); p1[2] += __uint_as_float(pw.w << 16); p1[3] += __uint_as_float(pw.w & 0xffff0000u); }
                    u32x4 w; w.x = cvt_pk_bf16(p0[0], p0[1]); w.y = cvt_pk_bf16(p0[2], p0[3]); w.z = cvt_pk_bf16(p1[0], p1[1]); w.w = cvt_pk_bf16(p1[2], p1[3]);
                    *(u32x4*)mp = w; } } }
    }
};
struct EpiSlab {
    static constexpr bool PERM = true, AFTER_DRAIN = false;
    float* slab;
    __device__ __forceinline__ void operator()(const f32x4 (&acc)[2][2][4][2], const Unit& u, int wr, int wc, int fr, int fq) const {
        const int row0 = wr * 64 + fr, col0 = wc * 32 + 8 * fq;
#pragma unroll
        for (int ai = 0; ai < 2; ++ai)
#pragma unroll
            for (int m = 0; m < 4; ++m)
#pragma unroll
                for (int bj = 0; bj < 2; ++bj) { float* p = slab + (row0 + ai * HALF + m * 16) * 256 + col0 + bj * HALF;
                    *(f32x4*)p = acc[ai][bj][m][0]; *(f32x4*)(p + 4) = acc[ai][bj][m][1]; }
    }
};
struct EpiGate {
    static constexpr bool PERM = true, AFTER_DRAIN = false;
    bf16_t* O; int ldc;
    __device__ __forceinline__ void operator()(const f32x4 (&acc)[2][2][4][2], const Unit& u, int wr, int wc, int fr, int fq) const {
        const int row0 = u.pm * BM + wr * 64 + fr, col0 = u.pn * BM + wc * 32 + 8 * fq;
#pragma unroll
        for (int ai = 0; ai < 2; ++ai)
#pragma unroll
            for (int m = 0; m < 4; ++m) { bf16_t* rowp = O + (size_t)(row0 + ai * HALF + m * 16) * ldc + col0;
#pragma unroll
                for (int bj = 0; bj < 2; ++bj) { const i32x4 a0 = __builtin_bit_cast(i32x4, acc[ai][bj][m][0]), a1 = __builtin_bit_cast(i32x4, acc[ai][bj][m][1]);
                    u32x4 w; w.x = cvt_pk_bf16((float)a0[0] * 0.0009765625f, (float)a0[1] * 0.0009765625f); w.y = cvt_pk_bf16((float)a0[2] * 0.0009765625f, (float)a0[3] * 0.0009765625f);
                    w.z = cvt_pk_bf16((float)a1[0] * 0.0009765625f, (float)a1[1] * 0.0009765625f); w.w = cvt_pk_bf16((float)a1[2] * 0.0009765625f, (float)a1[3] * 0.0009765625f);
                    *(u32x4*)(rowp + bj * HALF) = w; } }
    }
};
struct EpiRes {
    static constexpr bool PERM = false, AFTER_DRAIN = false;
    const float* base; float* out; int ldc;
    __device__ __forceinline__ void operator()(const f32x4 (&acc)[2][2][4][2], const Unit& u, int wr, int wc, int fr, int fq) const {
        const int row0 = u.pm * BM + wr * 64 + fr, col0 = u.pn * BM + wc * 32 + 4 * fq;
#pragma unroll
        for (int ai = 0; ai < 2; ++ai) {
            f32x4 bq[4][2][2];
#pragma unroll
            for (int m = 0; m < 4; ++m) { const size_t off = (size_t)(row0 + ai * HALF + m * 16) * ldc + col0;
#pragma unroll
                for (int bj = 0; bj < 2; ++bj)
#pragma unroll
                    for (int n = 0; n < 2; ++n) bq[m][bj][n] = *(const f32x4*)(base + off + bj * HALF + n * 16); }
#pragma unroll
            for (int m = 0; m < 4; ++m) { const size_t off = (size_t)(row0 + ai * HALF + m * 16) * ldc + col0;
#pragma unroll
                for (int bj = 0; bj < 2; ++bj)
#pragma unroll
                    for (int n = 0; n < 2; ++n) *(f32x4*)(out + off + bj * HALF + n * 16) = bq[m][bj][n] + acc[ai][bj][m][n]; } }
    }
};
template <class Epi, class Sched, bool ALIGN_EPI = false, bool SP2 = false, int DT = 0  >
__device__ __forceinline__ void gemm_phase(PG8_LAS unsigned char* lds, const Gemm g, const Sched& S, const Epi& E) {
    int tid_ = threadIdx.x; asm volatile("" : "+v"(tid_));
    const int tid = tid_, wid = __builtin_amdgcn_readfirstlane(tid >> 6), lane = tid & 63, wr = wid >> 2, wc = wid & 3, fr = lane & 15, fq = lane >> 4;
    const int K = g.K, nt = K / BK, LD = g.ld ? g.ld : g.K;
    unsigned voffA[2], voffB[2];
#pragma unroll
    for (int i = 0; i < 2; ++i) { int R, C; stage_rc(tid * 16 + i * 8192, R, C); const int Rb = Epi::PERM ? ((R & ~31) + perm32(R & 31)) : R;
        voffA[i] = (unsigned)(R * LD + C) * 2u; voffB[i] = (unsigned)(Rb * LD + C) * 2u; }
    const size_t kstep = (size_t)(BK * 2);
    const size_t hstep = (size_t)HALF * LD * 2;
    const size_t tstep = 2 * hstep;
    const unsigned ldsw = (unsigned)wid * 1024u;
    const int aoff = lds_byte(wr * 64 + fr, fq * 8), boff = lds_byte(wc * 32 + fr, fq * 8);
#define PG8_SA(b, h) (((b) * 2 + (h)) * HTB)
#define PG8_SB(b, h) ((4 + (b) * 2 + (h)) * HTB)
#define PG8_STAGE(bufoff, gbase, voff) do { _Pragma("unroll") for (int _i = 0; _i < 2; ++_i) \
        __builtin_amdgcn_global_load_lds((const unsigned*)((const char*)(gbase) + (voff)[_i]), (PG8_LAS unsigned*)(lds + (bufoff) + ldsw + _i * 8192), 16, 0, 0); } while (0)
#define PG8_LDA(dst, b, h) do { _Pragma("unroll") for (int m = 0; m < 4; ++m) _Pragma("unroll") for (int k = 0; k < 2; ++k) dst[m][k] = *(const PG8_LAS bf16x8*)(lds + PG8_SA(b, h) + aoff + m * 2048 + k * 1024); } while (0)
#define PG8_LDB(dst, b, h) do { _Pragma("unroll") for (int n = 0; n < 2; ++n) _Pragma("unroll") for (int k = 0; k < 2; ++k) dst[n][k] = *(const PG8_LAS bf16x8*)(lds + PG8_SB(b, h) + boff + n * 2048 + k * 1024); } while (0)
#define PG8_MMA(ai, bj, At, Bt) do { __builtin_amdgcn_s_setprio(1); \
        if constexpr (DT == 0) { _Pragma("unroll") for (int m = 0; m < 4; ++m) _Pragma("unroll") for (int n = 0; n < 2; ++n) _Pragma("unroll") for (int k = 0; k < 2; ++k) \
            acc[ai][bj][m][n] = mma16<DT>(Bt[n][k], At[m][k], acc[ai][bj][m][n]); } \
        else { _Pragma("unroll") for (int k = 0; k < 2; ++k) _Pragma("unroll") for (int m = 0; m < 4; ++m) _Pragma("unroll") for (int n = 0; n < 2; ++n)     \
            acc[ai][bj][m][n] = mma16<DT>(Bt[n][k], At[m][k], acc[ai][bj][m][n]); } \
        __builtin_amdgcn_s_setprio(0); } while (0)
#define PG8_WAIT_V(n) asm volatile("s_waitcnt vmcnt(" #n ")" ::: "memory")
#define PG8_WAIT_L(n) asm volatile("s_waitcnt lgkmcnt(" #n ")" ::: "memory")
#define PG8_BAR __builtin_amdgcn_s_barrier()
#define PG8_SCHED __builtin_amdgcn_sched_barrier(0)
    Unit cur, nxt; int ui = 0;
    if (!S.next(0, cur)) return;
    f32x4 acc[2][2][4][2];
#pragma unroll
    for (int a = 0; a < 2; ++a)
#pragma unroll
        for (int b = 0; b < 2; ++b)
#pragma unroll
            for (int m = 0; m < 4; ++m)
#pragma unroll
                for (int n = 0; n < 2; ++n) acc[a][b][m][n] = (f32x4){0.f, 0.f, 0.f, 0.f};
    bf16x8 At[4][2], B0[2][2], B1[2][2];
    const char* cA = (const char*)g.A + (size_t)cur.pm * tstep; const char* cB = (const char*)g.Bt + (size_t)cur.pn * tstep;
    S.a_ready(cur);
    if constexpr (SP2) {
        PG8_STAGE(PG8_SB(0, 0), cB, voffB); PG8_STAGE(PG8_SB(0, 1), cB + hstep, voffB); PG8_STAGE(PG8_SA(0, 0), cA, voffA); PG8_STAGE(PG8_SA(0, 1), cA + hstep, voffA);
        if (wr == 1) PG8_BAR;
        PG8_WAIT_V(2); PG8_BAR;
        PG8_STAGE(PG8_SB(1, 0), cB + kstep, voffB); PG8_STAGE(PG8_SA(1, 0), cA + kstep, voffA); PG8_STAGE(PG8_SB(1, 1), cB + hstep + kstep, voffB);
        PG8_WAIT_V(6); PG8_BAR;
    } else {
        PG8_STAGE(PG8_SB(0, 0), cB, voffB); PG8_STAGE(PG8_SA(0, 0), cA, voffA); PG8_STAGE(PG8_SB(0, 1), cB + hstep, voffB); PG8_STAGE(PG8_SA(0, 1), cA + hstep, voffA);
        if (wr == 1) PG8_BAR;
        PG8_WAIT_V(4); PG8_BAR;
        PG8_STAGE(PG8_SB(1, 0), cB + kstep, voffB); PG8_STAGE(PG8_SA(1, 0), cA + kstep, voffA); PG8_STAGE(PG8_SB(1, 1), cB + hstep + kstep, voffB);
        PG8_WAIT_V(6); PG8_BAR;
    }
    for (;;) {
        const bool has_next = S.next(ui + 1, nxt);
        const char* nA = has_next ? (const char*)g.A + (size_t)nxt.pm * tstep : cA; const char* nB = has_next ? (const char*)g.Bt + (size_t)nxt.pn * tstep : cB;
        for (int t = 0; t < nt; t += 2) {
            const bool last = (t == nt - 2);
            const char* a1 = cA + (size_t)(t + 1) * kstep;
            const char* a2 = last ? nA : cA + (size_t)(t + 2) * kstep; const char* b2 = last ? nB : cB + (size_t)(t + 2) * kstep;
            const char* a3 = a2 + kstep; const char* b3 = b2 + kstep;
            if (last && has_next) S.a_ready(nxt);
            if constexpr (SP2) {
            PG8_LDB(B0, 0, 0); PG8_LDB(B1, 0, 1); PG8_SCHED; PG8_LDA(At, 0, 0); PG8_STAGE(PG8_SA(1, 1), a1 + hstep, voffA);
            PG8_WAIT_V(8); PG8_WAIT_L(0); PG8_BAR; PG8_MMA(0, 0, At, B0); PG8_MMA(0, 1, At, B1); PG8_BAR; PG8_SCHED;
            PG8_LDA(At, 0, 1); PG8_STAGE(PG8_SB(0, 0), b2, voffB); PG8_STAGE(PG8_SB(0, 1), b2 + hstep, voffB); PG8_STAGE(PG8_SA(0, 0), a2, voffA);
            PG8_WAIT_V(8); PG8_WAIT_L(0); PG8_BAR; PG8_MMA(1, 0, At, B0); PG8_MMA(1, 1, At, B1); PG8_BAR; PG8_SCHED;
            PG8_LDB(B0, 1, 0); PG8_LDB(B1, 1, 1); PG8_SCHED; PG8_LDA(At, 1, 0); PG8_STAGE(PG8_SA(0, 1), a2 + hstep, voffA);
            PG8_WAIT_V(8); PG8_WAIT_L(0); PG8_BAR; PG8_MMA(0, 0, At, B0); PG8_MMA(0, 1, At, B1); PG8_BAR; PG8_SCHED;
            PG8_LDA(At, 1, 1); PG8_STAGE(PG8_SB(1, 0), b3, voffB); PG8_STAGE(PG8_SB(1, 1), b3 + hstep, voffB); PG8_STAGE(PG8_SA(1, 0), a3, voffA);
            PG8_WAIT_V(8); PG8_WAIT_L(0); PG8_BAR; PG8_MMA(1, 0, At, B0); PG8_MMA(1, 1, At, B1); PG8_BAR; PG8_SCHED;
            } else {
            PG8_LDB(B0, 0, 0); PG8_SCHED; PG8_LDA(At, 0, 0); PG8_STAGE(PG8_SA(1, 1), a1 + hstep, voffA);
            PG8_WAIT_L(8); PG8_BAR; PG8_WAIT_L(0); PG8_MMA(0, 0, At, B0); PG8_BAR; PG8_SCHED;
            PG8_LDB(B1, 0, 1); PG8_STAGE(PG8_SB(0, 0), b2, voffB);
            PG8_BAR; PG8_WAIT_L(0); PG8_MMA(0, 1, At, B1); PG8_BAR;
            PG8_LDA(At, 0, 1); PG8_STAGE(PG8_SA(0, 0), a2, voffA);
            PG8_BAR; PG8_WAIT_L(0); PG8_MMA(1, 0, At, B0); PG8_BAR; PG8_SCHED;
            PG8_STAGE(PG8_SB(0, 1), b2 + hstep, voffB);
            PG8_WAIT_V(6); PG8_BAR; PG8_MMA(1, 1, At, B1); PG8_BAR;
            PG8_LDB(B0, 1, 0); PG8_SCHED; PG8_LDA(At, 1, 0); PG8_STAGE(PG8_SA(0, 1), a2 + hstep, voffA);
            PG8_WAIT_L(8); PG8_BAR; PG8_WAIT_L(0); PG8_MMA(0, 0, At, B0); PG8_BAR; PG8_SCHED;
            PG8_LDB(B1, 1, 1); PG8_STAGE(PG8_SB(1, 0), b3, voffB);
            PG8_BAR; PG8_WAIT_L(0); PG8_MMA(0, 1, At, B1); PG8_BAR;
            PG8_LDA(At, 1, 1); PG8_STAGE(PG8_SA(1, 0), a3, voffA);
            PG8_BAR; PG8_WAIT_L(0); PG8_MMA(1, 0, At, B0); PG8_BAR; PG8_SCHED;
            PG8_STAGE(PG8_SB(1, 1), b3 + hstep, voffB);
            PG8_WAIT_V(6); PG8_BAR; PG8_MMA(1, 1, At, B1); PG8_BAR;
            }
        }
        if constexpr (ALIGN_EPI) { if (wr == 0) PG8_BAR; }
        if constexpr (!Epi::AFTER_DRAIN) { E(acc, cur, wr, wc, fr, fq); S.done(cur); }
        if (!has_next) break;
#pragma unroll
        for (int a = 0; a < 2; ++a)
#pragma unroll
            for (int b = 0; b < 2; ++b)
#pragma unroll
                for (int m = 0; m < 4; ++m)
#pragma unroll
                    for (int n = 0; n < 2; ++n) acc[a][b][m][n] = (f32x4){0.f, 0.f, 0.f, 0.f};
        cur = nxt; cA = nA; cB = nB; ++ui;
        if constexpr (ALIGN_EPI) { if (wr == 1) PG8_BAR; }
    }
    PG8_WAIT_V(0);
    if constexpr (!ALIGN_EPI) { if (wr == 0) PG8_BAR; }
    PG8_BAR;
    if constexpr (Epi::AFTER_DRAIN) { E.fused(acc, cur, wr, wc, fr, fq, lds, wid, lane); S.done(cur); }
#undef PG8_SA
#undef PG8_SB
#undef PG8_STAGE
#undef PG8_LDA
#undef PG8_LDB
#undef PG8_MMA
#undef PG8_WAIT_V
#undef PG8_WAIT_L
#undef PG8_BAR
#undef PG8_SCHED
}
}
constexpr int NWAVES = 8;
constexpr int BATCH = 2, SEQ = 8192, DM = 4096, MTOK = BATCH * SEQ, DEPTH = 2;
constexpr int NIN = 36000, NP = 36096;
constexpr int BW = 2048;
constexpr int C_RQ = 0, C_RK = 2048, C_RV = 4096, C_RG = 6144, C_DQ = 8192, C_DK = 10240, C_DV = 10752, C_IQ = 11264, C_IK = 15360, C_IW = 15488,
              C_DG = 15616, C_GU = 17664, C_GV = 19712, C_GG = 21760, C_MG = 23808;
constexpr int PAD_AT = 15520, PAD_N = 96;
constexpr float EPS = 1e-6f;
constexpr int NPHASE = 1 + 8 * DEPTH;
#ifndef G1_SPLIT
#define G1_SPLIT false
#endif
#ifndef GATE_I8
#define GATE_I8 1
#endif
#ifndef MK_PER_PHASE
#define MK_PER_PHASE 0
#endif

constexpr size_t MiB = 1ull << 20;
constexpr size_t WS_CTL = 0, CTL_ZERO_BYTES = 1 * MiB;
constexpr size_t WIN_BYTES = (size_t)NP * DM * 2;
constexpr size_t WS_WIN = 2 * MiB;
constexpr size_t WS_WBR = WS_WIN + DEPTH * WIN_BYTES;
constexpr size_t WBR_BYTES = (size_t)DM * BW * 2;
constexpr size_t WS_WOUT = WS_WBR + DEPTH * 3 * WBR_BYTES;
constexpr size_t WOUT_BYTES = (size_t)DM * DM * 2;
constexpr size_t WS_ROPE = WS_WOUT + DEPTH * WOUT_BYTES;
constexpr size_t WS_XN = WS_ROPE + 24 * MiB;
constexpr size_t WS_H = WS_XN + 128 * MiB;
constexpr size_t WS_X1 = WS_H + (size_t)MTOK * NP * 2;
constexpr size_t WS_SC = WS_X1 + 256 * MiB;
constexpr size_t WS_SEL = WS_SC + 512 * MiB;
constexpr size_t WS_KVP = WS_SEL + 16 * MiB;
constexpr size_t WS_RST = WS_KVP + 256 * MiB;
constexpr size_t WS_SS = WS_RST + 256 * MiB;
constexpr size_t WS_OUTF = WS_SS + 64 * MiB;
constexpr size_t WS_Y = WS_OUTF + 128 * MiB;
constexpr size_t WS_M32 = WS_Y + 192 * MiB;
constexpr size_t WS_MB = WS_M32 + 256 * MiB;
constexpr size_t WS_GVS = WS_MB + 128 * MiB;
constexpr size_t WS_IQP = WS_GVS + 1 * MiB;
constexpr size_t WS_WSB = WS_IQP + 128 * MiB;
constexpr size_t WS_XQ = WS_WSB + 1 * MiB;
constexpr size_t WS_WQ = WS_WIN;
constexpr size_t WQ_BYTES = (size_t)NP * DM;
constexpr size_t WS_RSC = WS_XQ + 64 * MiB;
constexpr size_t WS_K8 = WS_RSC + 1 * MiB;
constexpr size_t WS_V8 = WS_K8 + 8 * MiB;
constexpr size_t WS_END = WS_V8 + 8 * MiB;
constexpr int CW_BAR = 4096;
constexpr int CW_TK = 1024;
constexpr int CW_QIDX = 64;
constexpr int LDS_BYTES = 147456;
constexpr int MISC_OFF = LDS_BYTES - 256;

#define GAS __attribute__((address_space(1)))
#define LAS __attribute__((address_space(3)))
typedef unsigned short bf16;
typedef unsigned v4u __attribute__((ext_vector_type(4)));
typedef float f32x4 __attribute__((ext_vector_type(4)));
typedef float f32x16 __attribute__((ext_vector_type(16)));
typedef short bf16x8 __attribute__((ext_vector_type(8)));
constexpr int NG = 3 * DM;
constexpr int NIN_BF = NIN - NG;
#define LDS_WAIT() asm volatile("s_waitcnt lgkmcnt(0)" ::: "memory")
#define VM_WAIT() asm volatile("s_waitcnt vmcnt(0)" ::: "memory")
__device__ __forceinline__ float bf2f(unsigned short b) { return __uint_as_float(((unsigned)b) << 16); }
__device__ __forceinline__ unsigned f2bf(float f) { unsigned u = __float_as_uint(f); return (u + 0x7fffu + ((u >> 16) & 1u)) >> 16; }
__device__ __forceinline__ unsigned pk2(float lo, float hi) { return f2bf(lo) | (f2bf(hi) << 16); }
__device__ __forceinline__ float lo16(unsigned w) { return __uint_as_float(w << 16); }
__device__ __forceinline__ float hi16(unsigned w) { return __uint_as_float(w & 0xffff0000u); }
__device__ __forceinline__ int lane_now() { int l = (int)__builtin_amdgcn_mbcnt_hi(~0u, __builtin_amdgcn_mbcnt_lo(~0u, 0u)); asm volatile("" : "+v"(l)); return l; }
template <int O> __device__ __forceinline__ float shx(float v) {
    if constexpr (O < 32) return __int_as_float(__builtin_amdgcn_ds_swizzle(__float_as_int(v), (O << 10) | 0x1f));
    else return __int_as_float(__builtin_amdgcn_ds_bpermute((lane_now() ^ O) << 2, __float_as_int(v)));
}
__device__ __forceinline__ unsigned sh_up(unsigned v, int o) { return (unsigned)__builtin_amdgcn_ds_bpermute((lane_now() - o) << 2, (int)v); }
__device__ __forceinline__ unsigned sh_idx(unsigned v, int src) { return (unsigned)__builtin_amdgcn_ds_bpermute(src << 2, (int)v); }
__device__ __forceinline__ float wave_sum(float v) { v += shx<1>(v); v += shx<2>(v); v += shx<4>(v); v += shx<8>(v); v += shx<16>(v); v += shx<32>(v); return v; }
__device__ __forceinline__ float wave_max(float v) { v = fmaxf(v, shx<1>(v)); v = fmaxf(v, shx<2>(v)); v = fmaxf(v, shx<4>(v)); v = fmaxf(v, shx<8>(v)); v = fmaxf(v, shx<16>(v)); v = fmaxf(v, shx<32>(v)); return v; }

#define XB_TMO      128
#define XB_XCNT(j)  (256  + 64 * (j))
#define XB_XSUB(j)  (1280 + 64 * (j))
#define XB_XGEN(j)  (2304 + 64 * (j))
#define XB_TOP      3328
#define XB_TOPGEN   3392
#define XCD_BAR_WORDS 3456
#define XB_SPIN_CAP (1u << 22)

__device__ __forceinline__ unsigned xb_ld(unsigned* p)              { return __hip_atomic_load(p, __ATOMIC_RELAXED, __HIP_MEMORY_SCOPE_AGENT); }
__device__ __forceinline__ unsigned xb_add(unsigned* p, unsigned v) { return __hip_atomic_fetch_add(p, v, __ATOMIC_RELAXED, __HIP_MEMORY_SCOPE_AGENT); }
__device__ __forceinline__ unsigned xb_xcc_id() { return (unsigned)__builtin_amdgcn_s_getreg((3 << 11) | 20) & 0xFu; }
#define XB_SPIN(cond, bar) do { unsigned _sp = 0; while (cond) { __builtin_amdgcn_s_sleep(1); \
    if ((++_sp & 255u) == 0u) { if (xb_ld(&(bar)[XB_TMO])) break; if (_sp > XB_SPIN_CAP) { atomicAdd(&(bar)[XB_TMO], 1u); break; } } } } while (0)

struct XcdBarrier {
    unsigned* bar; unsigned x;
    volatile LAS unsigned* st;
};

__device__ __forceinline__ XcdBarrier xcd_barrier_post(unsigned* bar, volatile LAS unsigned* st) {
    XcdBarrier b; b.bar = bar; b.x = xb_xcc_id(); b.st = st;
    if (threadIdx.x == 0) (void)xb_add(&bar[XB_XCNT(b.x)], 1u);
    return b;
}
__device__ __forceinline__ void xcd_barrier_complete(unsigned* bar, unsigned x, unsigned& nloc, unsigned& nx) {
    const unsigned G = gridDim.x * gridDim.y * gridDim.z;
    unsigned sum, cnt, mine, sp = 0u;
    for (;;) {
        sum = 0u; cnt = 0u; mine = 0u;
#pragma unroll
        for (unsigned j = 0; j < 16; ++j) { const unsigned c = xb_ld(&bar[XB_XCNT(j)]); sum += c; cnt += (c > 0u) ? 1u : 0u; mine = (j == x) ? c : mine; }
        if (sum == G) break;
        __builtin_amdgcn_s_sleep(1);
        if ((++sp & 255u) == 0u) { if (xb_ld(&bar[XB_TMO])) break; if (sp > XB_SPIN_CAP) { atomicAdd(&bar[XB_TMO], 1u); break; } }
    }
    nloc = mine > 0u ? mine : 1u; nx = cnt > 0u ? cnt : 1u;
}

__device__ __forceinline__ void xcd_barrier(const XcdBarrier& b) {
    asm volatile("s_waitcnt vmcnt(0)" ::: "memory");
    __syncthreads();
    if (threadIdx.x == 0) {
        unsigned* bar = b.bar;
        __builtin_amdgcn_s_waitcnt(0);
        unsigned nloc = b.st[0], nx = b.st[1];
        if (nloc == 0u) { xcd_barrier_complete(bar, b.x, nloc, nx); b.st[0] = nloc; b.st[1] = nx; }
        const unsigned old = xb_add(&bar[XB_XSUB(b.x)], 1u);
        const unsigned gen = old / nloc;
        if (old + 1u == (gen + 1u) * nloc) {
            __builtin_amdgcn_fence(__ATOMIC_RELEASE, "agent");
            asm volatile("s_waitcnt vmcnt(0)" ::: "memory");
            const unsigned og = xb_add(&bar[XB_TOP], 1u);
            const unsigned tg = og / nx;
            if (og + 1u == (tg + 1u) * nx) xb_add(&bar[XB_TOPGEN], 1u);
            else XB_SPIN(xb_ld(&bar[XB_TOPGEN]) == tg, bar);
            __builtin_amdgcn_fence(__ATOMIC_ACQUIRE, "agent");
            xb_add(&bar[XB_XGEN(b.x)], 1u);
            asm volatile("s_waitcnt vmcnt(0)" ::: "memory");
        } else {
            XB_SPIN(xb_ld(&bar[XB_XGEN(b.x)]) == gen, bar);
            __builtin_amdgcn_fence(__ATOMIC_ACQUIRE, "agent");
            asm volatile("s_waitcnt vmcnt(0)" ::: "memory");
        }
    }
    __syncthreads();
}

struct Args { const float* in[12]; float* out; unsigned char* ws; int ph_lo, ph_hi; };
struct Ctx { LAS unsigned char* lds; int tid, lane, wave, G, bx; };
enum { IN_X = 0, IN_POS, IN_NG, IN_WIN, IN_RNG, IN_QNG, IN_KNG, IN_GMG, IN_WS, IN_BS, IN_WBR, IN_WOUT };

__device__ __forceinline__ void transpose_item(const float* W, int K, int N, int nblk, bf16* WT, int item, int pad_at, int pad_n, LAS float* scr, int lane) {
    const int kb = item / nblk, nb = item % nblk, k0 = 64 * kb, n0 = 32 * nb;
    const int row_off = (n0 >= pad_at) ? pad_n : 0;
    { const int r8 = lane >> 3, c4 = lane & 7; f32x4 v[8];
#pragma unroll
      for (int i = 0; i < 8; ++i) v[i] = *(const f32x4*)(W + (size_t)(k0 + 8 * i + r8) * N + n0 + 4 * c4);
#pragma unroll
      for (int i = 0; i < 8; ++i)
#pragma unroll
          for (int j = 0; j < 4; ++j) scr[(8 * i + r8) * 33 + 4 * c4 + j] = v[i][j]; }
    LDS_WAIT(); asm volatile("" ::: "memory");
    const int c = lane & 7;
#pragma unroll
    for (int j = 0; j < 4; ++j) { const int n = (lane >> 3) + 8 * j; const LAS float* s = scr + (8 * c) * 33 + n;
        v4u o; o.x = pk2(s[0 * 33], s[1 * 33]); o.y = pk2(s[2 * 33], s[3 * 33]); o.z = pk2(s[4 * 33], s[5 * 33]); o.w = pk2(s[6 * 33], s[7 * 33]);
        *(v4u*)(WT + (size_t)(row_off + n0 + n) * K + k0 + 8 * c) = o; }
    LDS_WAIT(); asm volatile("" ::: "memory");
}
__device__ __forceinline__ void ph_prologue(const Args& a, const Ctx& c) {
    LAS float* scr = (LAS float*)(c.lds + c.wave * 16384);
    const int gw = c.bx * NWAVES + c.wave, NGW = c.G * NWAVES;
    constexpr int I_IN = 0, I_BR = (BW / 64) * (DM / 32), I_OUT = (DM / 64) * (DM / 32);
    constexpr int NITEMS = DEPTH * I_IN + DEPTH * 3 * I_BR + DEPTH * I_OUT;
    for (int it = gw; it < NITEMS; it += NGW) {
        int r = it;
        r -= DEPTH * I_IN;
        if (r < DEPTH * 3 * I_BR) { const int li = r / I_BR; r -= li * I_BR;
            transpose_item(a.in[IN_WBR] + (size_t)li * BW * DM, BW, DM, DM / 32, (bf16*)(a.ws + WS_WBR + li * WBR_BYTES), r, 0x7fffffff, 0, scr, c.lane); continue; }
        r -= DEPTH * 3 * I_BR;
        { const int l = r / I_OUT; r -= l * I_OUT;
            transpose_item(a.in[IN_WOUT] + (size_t)l * DM * DM, DM, DM, DM / 32, (bf16*)(a.ws + WS_WOUT + l * WOUT_BYTES), r, 0x7fffffff, 0, scr, c.lane); }
    }
    { LAS float* cmax = (LAS float*)(c.lds + 131072);
      const int r8 = c.lane >> 3, c4 = c.lane & 7;
      for (int s = c.bx; s < DEPTH * (NIN / 32); s += c.G) { const int l = s / (NIN / 32), nb = s % (NIN / 32), nrow = 32 * nb + (32 * nb >= PAD_AT ? PAD_N : 0);
        const float* W = a.in[IN_WIN] + (size_t)l * DM * NIN + 32 * nb + 4 * c4;
        f32x4 mx = {0.f, 0.f, 0.f, 0.f};
        for (int it = 0; it < 8; ++it) { const int k0 = 512 * c.wave + 64 * it;
            f32x4 v[8];
#pragma unroll
            for (int i = 0; i < 8; ++i) v[i] = *(const f32x4*)(W + (size_t)(k0 + 8 * i + r8) * NIN);
#pragma unroll
            for (int i = 0; i < 8; ++i)
#pragma unroll
                for (int j = 0; j < 4; ++j) mx[j] = fmaxf(mx[j], fabsf(v[i][j])); }
#pragma unroll
        for (int j = 0; j < 4; ++j) { mx[j] = fmaxf(mx[j], shx<8>(mx[j])); mx[j] = fmaxf(mx[j], shx<16>(mx[j])); mx[j] = fmaxf(mx[j], shx<32>(mx[j])); }
        if (c.lane < 8) *(LAS f32x4*)(cmax + c.wave * 32 + 4 * c.lane) = mx;
        __syncthreads();
        f32x4 cm = {0.f, 0.f, 0.f, 0.f};
#pragma unroll
        for (int w8 = 0; w8 < 8; ++w8) { const f32x4 t = *(const LAS f32x4*)(cmax + w8 * 32 + 4 * c4);
#pragma unroll
            for (int j = 0; j < 4; ++j) cm[j] = fmaxf(cm[j], t[j]); }
        f32x4 inv;
#pragma unroll
        for (int j = 0; j < 4; ++j) inv[j] = cm[j] > 0.f ? 127.0f / cm[j] : 0.f;
        if (c.wave == 0 && c.lane < 8) *(f32x4*)((float*)(a.ws + WS_RSC) + DEPTH * MTOK + l * NP + nrow + 4 * c.lane) = cm * (1.0f / 127.0f);
        unsigned char* WQ = (unsigned char*)(a.ws + WS_WQ + l * WQ_BYTES);
        for (int it = 0; it < 8; ++it) { const int k0 = 512 * c.wave + 64 * it;
            f32x4 v[8];
#pragma unroll
            for (int i = 0; i < 8; ++i) v[i] = *(const f32x4*)(W + (size_t)(k0 + 8 * i + r8) * NIN);
#pragma unroll
            for (int i = 0; i < 8; ++i)
#pragma unroll
                for (int j = 0; j < 4; ++j) scr[(8 * i + r8) * 33 + 4 * c4 + j] = __builtin_rintf(v[i][j] * inv[j]);
            LDS_WAIT(); asm volatile("" ::: "memory");
            const int cc8 = c.lane & 7;
#pragma unroll
            for (int j = 0; j < 4; ++j) { const int n = (c.lane >> 3) + 8 * j; const LAS float* sp = scr + (8 * cc8) * 33 + n;
                const unsigned lo = ((unsigned)(int)sp[0 * 33] & 255u) | (((unsigned)(int)sp[1 * 33] & 255u) << 8) | (((unsigned)(int)sp[2 * 33] & 255u) << 16) | (((unsigned)(int)sp[3 * 33] & 255u) << 24);
                const unsigned hi = ((unsigned)(int)sp[4 * 33] & 255u) | (((unsigned)(int)sp[5 * 33] & 255u) << 8) | (((unsigned)(int)sp[6 * 33] & 255u) << 16) | (((unsigned)(int)sp[7 * 33] & 255u) << 24);
                *(unsigned long long*)(WQ + (size_t)(nrow + n) * DM + k0 + 8 * cc8) = (unsigned long long)lo | ((unsigned long long)hi << 32); }
            LDS_WAIT(); asm volatile("" ::: "memory"); }
        __syncthreads();
      } }
    const int gt = c.bx * (NWAVES * 64) + c.tid, NGT = c.G * NWAVES * 64;
    for (int i = gt; i < DEPTH * PAD_N * DM / 16; i += NGT) { const int l = i / (PAD_N * DM / 16), r = i % (PAD_N * DM / 16);
        *(v4u*)((unsigned char*)(a.ws + WS_WQ + l * WQ_BYTES) + (size_t)PAD_AT * DM + (size_t)r * 16) = (v4u){0u, 0u, 0u, 0u}; }
    if (gt < DEPTH * PAD_N) ((float*)(a.ws + WS_RSC))[DEPTH * MTOK + (gt / PAD_N) * NP + PAD_AT + gt % PAD_N] = 0.f;
    { const float* wsp = a.in[IN_WS]; bf16* WSB = (bf16*)(a.ws + WS_WSB);
      for (int i = gt; i < DEPTH * 16 * 128 * 128; i += NGT) { const int s = i & 127, t = (i >> 7) & 127; WSB[i] = (bf16)f2bf(s <= t ? wsp[i] : 0.f); } }
    const int* pos = (const int*)a.in[IN_POS];
    float* cosT = (float*)(a.ws + WS_ROPE); float* sinT = cosT + (size_t)MTOK * 128;
    for (int idx = gt; idx < MTOK * 128; idx += NGT) { const int m = idx >> 7, i = idx & 127;
        double p = 1.0, bb = 1.0746078283213174; int e = i; while (e) { if (e & 1) p *= bb; bb *= bb; e >>= 1; }
        const float pf = (float)p; const float inv = 1.0f / pf; const float ang = (float)pos[m] * inv;
        const double ad = (double)ang; const double kq = __builtin_rint(ad * 0.6366197723675814);
        double r = __builtin_fma(-kq, 1.5707963267948966, ad); r = __builtin_fma(-kq, 6.123233995736766e-17, r);
        const double r2 = r * r;
        const double sn = r * (1.0 + r2 * (-1.0 / 6 + r2 * (1.0 / 120 + r2 * (-1.0 / 5040 + r2 * (1.0 / 362880 + r2 * (-1.0 / 39916800 + r2 * (1.0 / 6227020800.0)))))));
        const double cs = 1.0 + r2 * (-0.5 + r2 * (1.0 / 24 + r2 * (-1.0 / 720 + r2 * (1.0 / 40320 + r2 * (-1.0 / 3628800 + r2 * (1.0 / 479001600.0 + r2 * (-1.0 / 87178291200.0)))))));
        const int q = (int)((long long)kq & 3);
        const double sv = q == 0 ? sn : q == 1 ? cs : q == 2 ? -sn : -cs, cv = q == 0 ? cs : q == 1 ? -sn : q == 2 ? -cs : sn;
        cosT[idx] = (float)cv; sinT[idx] = (float)sv;
        if ((i & 1) == 0) { cosT[(size_t)MTOK * 256 + (size_t)m * 64 + (i >> 1)] = (float)cv; cosT[(size_t)MTOK * 320 + (size_t)m * 64 + (i >> 1)] = (float)sv; } }
}

__device__ __forceinline__ void ph_norm(const Args& a, const Ctx& c, int l) {
    const float* src = (l == 0) ? a.in[IN_X] : (const float*)(a.ws + WS_X1);
    const float* gain = a.in[IN_NG] + (size_t)l * DM;
    unsigned char* XQ = (unsigned char*)(a.ws + WS_XQ);
    const int gw = c.bx * NWAVES + c.wave, NGW = c.G * NWAVES;
    for (int m = gw; m < MTOK; m += NGW) {
        const f32x4* xr = (const f32x4*)(src + (size_t)m * DM) + c.lane;
        f32x4 v[16]; float ss = 0.f;
#pragma unroll
        for (int j = 0; j < 16; ++j) { v[j] = xr[64 * j]; ss += (v[j][0] * v[j][0] + v[j][1] * v[j][1]) + (v[j][2] * v[j][2] + v[j][3] * v[j][3]); }
        const float r = 1.0f / sqrtf(wave_sum(ss) * (1.0f / DM) + EPS);
        float amax = 0.f;
#pragma unroll
        for (int j = 0; j < 16; ++j) { const f32x4 g4 = ((const f32x4*)gain)[c.lane + 64 * j];
            v[j][0] *= r * g4[0]; v[j][1] *= r * g4[1]; v[j][2] *= r * g4[2]; v[j][3] *= r * g4[3];
            amax = fmaxf(fmaxf(amax, fmaxf(fabsf(v[j][0]), fabsf(v[j][1]))), fmaxf(fabsf(v[j][2]), fabsf(v[j][3]))); }
        amax = wave_max(amax);
        const float qi = amax > 0.f ? 127.0f / amax : 0.f;
        unsigned* q4 = (unsigned*)(XQ + (size_t)m * DM) + c.lane;
#pragma unroll
        for (int j = 0; j < 16; ++j) q4[64 * j] = ((unsigned)(int)__builtin_rintf(v[j][0] * qi) & 255u) | (((unsigned)(int)__builtin_rintf(v[j][1] * qi) & 255u) << 8)
            | (((unsigned)(int)__builtin_rintf(v[j][2] * qi) & 255u) << 16) | (((unsigned)(int)__builtin_rintf(v[j][3] * qi) & 255u) << 24);
        if (c.lane == 0) ((float*)(a.ws + WS_RSC))[(size_t)l * MTOK + m] = amax * (1.0f / 127.0f);
    }
}

__device__ __forceinline__ void unpack8(const v4u w, float (&x)[8]) { x[0] = lo16(w.x); x[1] = hi16(w.x); x[2] = lo16(w.y); x[3] = hi16(w.y); x[4] = lo16(w.z); x[5] = hi16(w.z); x[6] = lo16(w.w); x[7] = hi16(w.w); }
__device__ __forceinline__ v4u pack8(const float (&x)[8]) { v4u o; o.x = pk2(x[0], x[1]); o.y = pk2(x[2], x[3]); o.z = pk2(x[4], x[5]); o.w = pk2(x[6], x[7]); return o; }
__device__ __forceinline__ unsigned long long pack8_fp8(const float (&x)[8]) {
    int w0 = __builtin_amdgcn_cvt_pk_fp8_f32(x[0], x[1], 0, false); w0 = __builtin_amdgcn_cvt_pk_fp8_f32(x[2], x[3], w0, true);
    int w1 = __builtin_amdgcn_cvt_pk_fp8_f32(x[4], x[5], 0, false); w1 = __builtin_amdgcn_cvt_pk_fp8_f32(x[6], x[7], w1, true);
    return (unsigned long long)(unsigned)w0 | ((unsigned long long)(unsigned)w1 << 32); }
typedef unsigned u32x2_t __attribute__((ext_vector_type(2)));
__device__ __forceinline__ v4u swap16_pair(unsigned aLo, unsigned aHi, unsigned bLo, unsigned bHi) {
    const u32x2_t l = __builtin_amdgcn_permlane16_swap(aLo, bLo, false, false), h = __builtin_amdgcn_permlane16_swap(aHi, bHi, false, false);
    return (v4u){l.x, h.x, l.y, h.y};
}
__device__ __forceinline__ void loadh(const bf16* hp, const LAS float* csl, float rsc, int col, float (&x)[8]) {
    unpack8(*(const v4u*)(hp + col), x); const f32x4 k0 = *(const LAS f32x4*)(csl + col), k1 = *(const LAS f32x4*)(csl + col + 4);
#pragma unroll
    for (int e = 0; e < 4; ++e) { x[e] *= rsc * k0[e]; x[4 + e] *= rsc * k1[e]; }
}
__device__ __forceinline__ void scaleh(const v4u raw, const LAS float* csl, float rsc, int col, float (&x)[8]) {
    unpack8(raw, x); const f32x4 k0 = *(const LAS f32x4*)(csl + col), k1 = *(const LAS f32x4*)(csl + col + 4);
#pragma unroll
    for (int e = 0; e < 4; ++e) { x[e] *= rsc * k0[e]; x[4 + e] *= rsc * k1[e]; }
}
template <int ACT> __device__ __forceinline__ void prep_seg(bf16* hp, const LAS float* csl, float rsc, int c0, int c1, int lane) {
    for (int col = c0 + lane * 8; col < c1; col += 512) { float x[8]; loadh(hp, csl, rsc, col, x);
        if (ACT != 0) {
#pragma unroll
            for (int e = 0; e < 8; ++e) x[e] = pg8::act_apply(x[e], ACT); }
        *(v4u*)(hp + col) = pack8(x); }
}
__device__ __forceinline__ void ph_prep(const Args& a, const Ctx& c, int l) {
    bf16* H = (bf16*)(a.ws + WS_H);
    const float* cosT = (const float*)(a.ws + WS_ROPE); const float* sinT = cosT + (size_t)MTOK * 128;
    const float* cos1 = cosT + (size_t)MTOK * 256; const float* sin1 = cosT + (size_t)MTOK * 320;
    const float* qg = a.in[IN_QNG] + l * 128; const float* kg = a.in[IN_KNG] + l * 128;
    float* GVS = (float*)(a.ws + WS_GVS); bf16* IQP = (bf16*)(a.ws + WS_IQP); unsigned char* K8 = (unsigned char*)(a.ws + WS_K8);
    const float* rsl = (const float*)(a.ws + WS_RSC) + (size_t)l * MTOK; const float* csg = (const float*)(a.ws + WS_RSC) + DEPTH * MTOK + l * NP;
    const LAS float* csl = (const LAS float*)c.lds;
    for (int i = c.tid; i < C_GG / 4; i += NWAVES * 64) *(LAS f32x4*)(c.lds + 16 * i) = *(const f32x4*)(csg + 4 * i);
    __syncthreads();
    const int gw = c.bx * NWAVES + c.wave, NGW = c.G * NWAVES, lane = c.lane;
    const int i2 = 8 * (lane & 15), h2 = lane >> 4;
    const int i1 = 8 * (lane & 7), h1 = lane >> 3;
    float gq0[8], gq1[8], gk0[8], gk1[8];
#pragma unroll
    for (int e = 0; e < 8; ++e) { gq0[e] = qg[i1 + e]; gq1[e] = qg[i1 + 64 + e]; gk0[e] = kg[i1 + e]; gk1[e] = kg[i1 + 64 + e]; }
    for (int m = gw; m < MTOK; m += NGW) {
        bf16* hp = H + (size_t)m * NP;
        const float rsc = rsl[m] * 1024.0f;
        float c2[8], s2[8], c1[8], s1[8];
        { const f32x4 a0 = *(const f32x4*)(cosT + (size_t)m * 128 + i2), a1 = *(const f32x4*)(cosT + (size_t)m * 128 + i2 + 4), b0 = *(const f32x4*)(sinT + (size_t)m * 128 + i2), b1 = *(const f32x4*)(sinT + (size_t)m * 128 + i2 + 4);
          const f32x4 d0 = *(const f32x4*)(cos1 + (size_t)m * 64 + i1), d1 = *(const f32x4*)(cos1 + (size_t)m * 64 + i1 + 4), e0 = *(const f32x4*)(sin1 + (size_t)m * 64 + i1), e1 = *(const f32x4*)(sin1 + (size_t)m * 64 + i1 + 4);
#pragma unroll
          for (int e = 0; e < 4; ++e) { c2[e] = a0[e]; c2[4 + e] = a1[e]; s2[e] = b0[e]; s2[4 + e] = b1[e]; c1[e] = d0[e]; c1[4 + e] = d1[e]; s1[e] = e0[e]; s1[4 + e] = e1[e]; } }
        v4u ra[4][2], rb[3][2], rdv;
#pragma unroll
        for (int it = 0; it < 4; ++it) { const int col = C_RQ + (4 * it + h2) * 256 + i2; ra[it][0] = *(const v4u*)(hp + col); ra[it][1] = *(const v4u*)(hp + col + 128); }
#pragma unroll
        for (int it = 0; it < 3; ++it) { const int hd = 8 * it + h1 < 20 ? 8 * it + h1 : 19, col = C_DQ + hd * 128 + i1; rb[it][0] = *(const v4u*)(hp + col); rb[it][1] = *(const v4u*)(hp + col + 64); }
        rdv = *(const v4u*)(hp + C_DV + lane * 8);
#pragma unroll
        for (int it = 0; it < 4; ++it) {
            const int col = C_RQ + (4 * it + h2) * 256 + i2; const float sc = it < 2 ? 1.0f : 0.0625f;
            float x1[8], x2[8], y1[8], y2[8]; scaleh(ra[it][0], csl, rsc, col, x1); scaleh(ra[it][1], csl, rsc, col + 128, x2);
#pragma unroll
            for (int e = 0; e < 8; ++e) { y1[e] = (x1[e] * c2[e] - x2[e] * s2[e]) * sc; y2[e] = (x2[e] * c2[e] + x1[e] * s2[e]) * sc; }
            *(v4u*)(hp + col) = pack8(y1); *(v4u*)(hp + col + 128) = pack8(y2);
        }
#pragma unroll
        for (int it = 0; it < 3; ++it) {
            const int hd = 8 * it + h1;
            if (hd < 20) { const int col = C_DQ + hd * 128 + i1;
                float x1[8], x2[8], y1[8], y2[8]; scaleh(rb[it][0], csl, rsc, col, x1); scaleh(rb[it][1], csl, rsc, col + 64, x2);
                float ss = 0.f;
#pragma unroll
                for (int e = 0; e < 8; ++e) ss += x1[e] * x1[e] + x2[e] * x2[e];
                ss += shx<1>(ss); ss += shx<2>(ss); ss += shx<4>(ss);
                const float r = 1.0f / sqrtf(ss * (1.0f / 128.0f) + EPS);
#pragma unroll
                for (int e = 0; e < 8; ++e) { const float u1 = x1[e] * r * (hd < 16 ? gq0[e] : gk0[e]), u2 = x2[e] * r * (hd < 16 ? gq1[e] : gk1[e]);
                    y1[e] = u1 * c1[e] - u2 * s1[e]; y2[e] = u2 * c1[e] + u1 * s1[e]; }
                *(v4u*)(hp + col) = pack8(y1); *(v4u*)(hp + col + 64) = pack8(y2);
                if (hd >= 16) { unsigned char* k8 = K8 + (size_t)m * 512 + (hd - 16) * 128 + i1;
                    *(unsigned long long*)k8 = pack8_fp8(y1); *(unsigned long long*)(k8 + 64) = pack8_fp8(y2); } }
        }
        { float x[8]; scaleh(rdv, csl, rsc, C_DV + lane * 8, x); *(unsigned long long*)((unsigned char*)(a.ws + WS_V8) + (size_t)m * 512 + lane * 8) = pack8_fp8(x); }
        bf16* iqp = IQP + (size_t)m * 4096;
        v4u rc[5][2], rgv[4], riw;
#pragma unroll
        for (int it = 0; it < 5; ++it) { const int hd = 8 * it + h1 < 33 ? 8 * it + h1 : 32, col = C_IQ + hd * 128 + i1; rc[it][0] = *(const v4u*)(hp + col); rc[it][1] = *(const v4u*)(hp + col + 64); }
#pragma unroll
        for (int j = 0; j < 4; ++j) rgv[j] = *(const v4u*)(hp + C_GV + (lane + 64 * j) * 8);
        riw = *(const v4u*)(hp + C_IW + (lane & 3) * 8);
#pragma unroll
        for (int it = 0; it < 5; ++it) {
            const int hd = 8 * it + h1;
            if (hd < 33) { const int col = C_IQ + hd * 128 + i1;
                float x1[8], x2[8], y1[8], y2[8]; scaleh(rc[it][0], csl, rsc, col, x1); scaleh(rc[it][1], csl, rsc, col + 64, x2);
#pragma unroll
                for (int e = 0; e < 8; ++e) { y1[e] = x1[e] * c1[e] - x2[e] * s1[e]; y2[e] = x2[e] * c1[e] + x1[e] * s1[e]; }
                if (hd < 32) { *(v4u*)(iqp + ((lane & 7) * 32 + hd) * 8) = pack8(y1); *(v4u*)(iqp + ((8 + (lane & 7)) * 32 + hd) * 8) = pack8(y2); }
                else { *(v4u*)(hp + col) = pack8(y1); *(v4u*)(hp + col + 64) = pack8(y2); } }
        }
        if (lane < 4) { float x[8]; scaleh(riw, csl, rsc, C_IW + lane * 8, x); *(v4u*)(hp + C_IW + lane * 8) = pack8(x); }
        {
            float v[32]; float s = 0.f;
#pragma unroll
            for (int j = 0; j < 4; ++j) { float x[8]; scaleh(rgv[j], csl, rsc, C_GV + (lane + 64 * j) * 8, x);
#pragma unroll
                for (int e = 0; e < 8; ++e) { x[e] = pg8::act_apply(x[e], 2); }
                const v4u w = pack8(x); *(v4u*)(hp + C_GV + (lane + 64 * j) * 8) = w;
                unpack8(w, x);
#pragma unroll
                for (int e = 0; e < 8; ++e) { v[8 * j + e] = x[e]; s += x[e]; } }
            const float mean = wave_sum(s) * (1.0f / 2048.0f); float q = 0.f;
#pragma unroll
            for (int j = 0; j < 32; ++j) { const float d = v[j] - mean; q += d * d; }
            const float rstd = 1.0f / sqrtf(wave_sum(q) * (1.0f / 2048.0f) + EPS);
            if (lane == 0) { GVS[2 * m] = mean; GVS[2 * m + 1] = rstd; }
        }
    }
}

typedef short s16x4 __attribute__((ext_vector_type(4)));
__device__ __forceinline__ float ret_logg(int h) { return logf(1.0f - exp2f(-5.0f - (float)h)); }
constexpr int RP = 528;
__device__ __forceinline__ bf16x8 tr8(const LAS unsigned char* p0, const LAS unsigned char* p1) {
    const s16x4 v0 = __builtin_amdgcn_ds_read_tr16_b64_v4i16((LAS s16x4*)p0), v1 = __builtin_amdgcn_ds_read_tr16_b64_v4i16((LAS s16x4*)p1);
    return (bf16x8){v0[0], v0[1], v0[2], v0[3], v1[0], v1[1], v1[2], v1[3]};
}
__device__ __forceinline__ void ph_ret_kv(const Args& a, const Ctx& c, int l, int u0, int ustep) {
    const bf16* H = (const bf16*)(a.ws + WS_H); float* KVT = (float*)(a.ws + WS_KVP);
    const float* rsl = (const float*)(a.ws + WS_RSC) + (size_t)l * MTOK; const float* csl = (const float*)(a.ws + WS_RSC) + DEPTH * MTOK + l * NP;
    LAS unsigned char* Kt = c.lds; LAS unsigned char* Vt = c.lds + 128 * RP;
    const int lane = c.lane, w = c.wave, tl = lane & 15, lg = lane >> 4, qq = (lane & 15) >> 2, pp = lane & 3;
    for (int u = u0; u < 1024; u += ustep) {
        const int b = u >> 9, h = (u >> 6) & 7, ck = u & 63, tok0 = b * SEQ + ck * 128;
        const float lgg = ret_logg(h);
#pragma unroll
        for (int i = 0; i < 8; ++i) { const int id = c.tid + 512 * i, row = id >> 5, ch = id & 31;
            *(LAS v4u*)(Kt + row * RP + ch * 16) = *(const v4u*)(H + (size_t)(tok0 + row) * NP + C_RK + h * 256 + ch * 8);
            const v4u x = *(const v4u*)(H + (size_t)(tok0 + row) * NP + C_RV + h * 256 + ch * 8);
            const float z = expf(lgg * (float)(127 - row)) * (rsl[tok0 + row] * 1024.0f);
            const f32x4 k0 = *(const f32x4*)(csl + C_RV + h * 256 + ch * 8), k1 = *(const f32x4*)(csl + C_RV + h * 256 + ch * 8 + 4);
            v4u o; o.x = pk2(lo16(x.x) * z * k0[0], hi16(x.x) * z * k0[1]); o.y = pk2(lo16(x.y) * z * k0[2], hi16(x.y) * z * k0[3]); o.z = pk2(lo16(x.z) * z * k1[0], hi16(x.z) * z * k1[1]); o.w = pk2(lo16(x.w) * z * k1[2], hi16(x.w) * z * k1[3]);
            *(LAS v4u*)(Vt + row * RP + ch * 16) = o; }
        __syncthreads();
        float* Ku = KVT + ((size_t)u << 16);
#pragma unroll 1
        for (int dh = 0; dh < 2; ++dh) {
            f32x4 acc[2][8];
#pragma unroll
            for (int i = 0; i < 2; ++i)
#pragma unroll
                for (int dt = 0; dt < 8; ++dt) acc[i][dt] = (f32x4){0.f, 0.f, 0.f, 0.f};
#pragma unroll 1
            for (int ks = 0; ks < 4; ++ks) {
                const LAS unsigned char* vb = Vt + (8 * lg + qq) * RP + (32 * w + 4 * pp) * 2 + 32 * ks * RP;
                const LAS unsigned char* kb = Kt + (8 * lg + qq) * RP + (128 * dh + 4 * pp) * 2 + 32 * ks * RP;
                bf16x8 af[2];
#pragma unroll
                for (int i = 0; i < 2; ++i) af[i] = tr8(vb + 32 * i, vb + 32 * i + 4 * RP);
#pragma unroll
                for (int dt = 0; dt < 8; ++dt) { const bf16x8 bfr = tr8(kb + 32 * dt, kb + 32 * dt + 4 * RP);
                    acc[0][dt] = __builtin_amdgcn_mfma_f32_16x16x32_bf16(af[0], bfr, acc[0][dt], 0, 0, 0);
                    acc[1][dt] = __builtin_amdgcn_mfma_f32_16x16x32_bf16(af[1], bfr, acc[1][dt], 0, 0, 0); }
            }
#pragma unroll
            for (int i = 0; i < 2; ++i)
#pragma unroll
                for (int dt = 0; dt < 8; ++dt)
#pragma unroll
                    for (int e = 0; e < 4; ++e) Ku[(32 * w + 16 * i + 4 * lg + e) * 256 + 128 * dh + 16 * dt + tl] = acc[i][dt][e];
        }
        __syncthreads();
    }
}
__device__ __forceinline__ void ph_ret_scan(const Args& a, const Ctx& c, int b0, int nb) {
    const float* KVT = (const float*)(a.ws + WS_KVP); bf16* RT = (bf16*)(a.ws + WS_RST);
    const int gt = b0 * (NWAVES * 64) + c.tid, NGT = nb * NWAVES * 64;
    for (int i = gt; i < 16 * 16384; i += NGT) {
        const int bh = i >> 14, q4 = i & 16383, h = bh & 7;
        const float cd = expf(ret_logg(h) * 128.0f);
        f32x4 r = {0.f, 0.f, 0.f, 0.f};
        for (int ck0 = 0; ck0 < 64; ck0 += 8) { f32x4 kv[8];
#pragma unroll
            for (int j = 0; j < 8; ++j) kv[j] = *(const f32x4*)(KVT + ((size_t)(bh * 64 + ck0 + j) << 16) + (size_t)q4 * 4);
#pragma unroll
            for (int j = 0; j < 8; ++j) { const size_t o = ((size_t)(bh * 64 + ck0 + j) << 16) + (size_t)q4 * 4;
                *(unsigned long long*)(RT + o) = (unsigned long long)pk2(r[0], r[1]) | ((unsigned long long)pk2(r[2], r[3]) << 32);
                r = r * cd + kv[j]; } }
    }
}
__device__ __forceinline__ void ph_ret_out(const Args& a, const Ctx& c, int l) {
    const bf16* H = (const bf16*)(a.ws + WS_H); const bf16* RT = (const bf16*)(a.ws + WS_RST); bf16* Y = (bf16*)(a.ws + WS_Y);
    const float* rng = a.in[IN_RNG] + l * BW;
    const float* rsl = (const float*)(a.ws + WS_RSC) + (size_t)l * MTOK; const float* csl = (const float*)(a.ws + WS_RSC) + DEPTH * MTOK + l * NP;
    LAS unsigned char* Kt = c.lds; LAS unsigned char* Vt = c.lds + 128 * RP;
    const int lane = c.lane, w = c.wave, tl = lane & 15, lg = lane >> 4, qq = (lane & 15) >> 2, pp = lane & 3;
    for (int u = c.bx; u < 1024; u += c.G) {
        const int b = u >> 9, h = (u >> 6) & 7, ck = u & 63, tok0 = b * SEQ + ck * 128;
        const float lgg = ret_logg(h);
        unsigned wb0 = (unsigned)((c.tid >> 5) * RP + (c.tid & 31) * 16), rb0 = (unsigned)(tl * RP + lg * 16);
        asm volatile("" : "+v"(wb0), "+v"(rb0)); unsigned wb1 = wb0 + 128 * RP, rb1 = rb0 + 128 * RP;
        asm volatile("" : "+v"(wb1), "+v"(rb1));
        {
            const char* Ru = (const char*)(RT + ((size_t)u << 16)); v4u rr[16]; const unsigned to = (unsigned)c.tid * 16u;
#pragma unroll
            for (int i = 0; i < 16; ++i) rr[i] = *(const v4u*)(Ru + i * 8192 + (size_t)to);
#pragma unroll
            for (int i = 0; i < 16; ++i) *(LAS v4u*)(c.lds + (i < 8 ? wb0 : wb1) + (i & 7) * 16 * RP) = rr[i];
        }
        __builtin_amdgcn_sched_barrier(0);
        const int n = 16 * w + tl;
        bf16x8 qf[8];
#pragma unroll
        for (int ks = 0; ks < 8; ++ks) qf[ks] = *(const bf16x8*)(H + (size_t)(tok0 + n) * NP + C_RQ + h * 256 + 32 * ks + 8 * lg);
        v4u kst[8], vst[8];
        { const unsigned ko = (unsigned)(((c.tid >> 5) * NP + (c.tid & 31) * 8) * 2);
#pragma unroll
          for (int i = 0; i < 8; ++i) { const char* kb_ = (const char*)(H + (size_t)(tok0 + 16 * i) * NP + C_RK + h * 256);
            kst[i] = *(const v4u*)(kb_ + (size_t)ko); vst[i] = *(const v4u*)(kb_ + (C_RV - C_RK) * 2 + (size_t)ko); } }
        __syncthreads();
        f32x4 acc[16];
#pragma unroll
        for (int et = 0; et < 16; ++et) { f32x4 s = {0.f, 0.f, 0.f, 0.f};
#pragma unroll
            for (int ks = 0; ks < 8; ++ks) { const bf16x8 rf = *(const LAS bf16x8*)(c.lds + (et < 8 ? rb0 : rb1) + (et & 7) * 16 * RP + 64 * ks); s = __builtin_amdgcn_mfma_f32_16x16x32_bf16(rf, qf[ks], s, 0, 0, 0); }
            acc[et] = s * expf(lgg * (float)(n + 1)); }
        __builtin_amdgcn_sched_barrier(0);
        const f32x4 vk0 = *(const f32x4*)(csl + C_RV + h * 256 + (c.tid & 31) * 8), vk1 = *(const f32x4*)(csl + C_RV + h * 256 + (c.tid & 31) * 8 + 4);
        __syncthreads();
#pragma unroll
        for (int i = 0; i < 8; ++i) { *(LAS v4u*)(c.lds + wb0 + i * 16 * RP) = kst[i];
            float xv[8]; unpack8(vst[i], xv);
#pragma unroll
            for (int e = 0; e < 4; ++e) { xv[e] *= vk0[e]; xv[4 + e] *= vk1[e]; }
            *(LAS v4u*)(c.lds + wb1 + i * 16 * RP) = pack8(xv); }
        __syncthreads();
        s16x4 P[8];
#pragma unroll
        for (int mt = 0; mt < 8; ++mt) { P[mt] = (s16x4){0, 0, 0, 0};
            if (mt <= w) { f32x4 s = {0.f, 0.f, 0.f, 0.f};
#pragma unroll
                for (int ks = 0; ks < 8; ++ks) { const bf16x8 kf = *(const LAS bf16x8*)(Kt + (16 * mt + tl) * RP + (32 * ks + 8 * lg) * 2); s = __builtin_amdgcn_mfma_f32_16x16x32_bf16(kf, qf[ks], s, 0, 0, 0); }
                float pv[4]; const f32x4 rs4 = *(const f32x4*)(rsl + tok0 + 16 * mt + 4 * lg);
#pragma unroll
                for (int e = 0; e < 4; ++e) { const int m = 16 * mt + 4 * lg + e; pv[e] = (m <= n) ? s[e] * expf(lgg * (float)(n - m)) * (rs4[e] * 1024.0f) : 0.f; }
                typedef unsigned u32x2 __attribute__((ext_vector_type(2)));
                const u32x2 pw = {pk2(pv[0], pv[1]), pk2(pv[2], pv[3])}; P[mt] = __builtin_bit_cast(s16x4, pw); } }
#pragma unroll
        for (int mt = 0; mt < 8; ++mt) { if (mt <= w) {
#pragma unroll
            for (int et = 0; et < 16; ++et) { const s16x4 vf = __builtin_amdgcn_ds_read_tr16_b64_v4i16((LAS s16x4*)(Vt + (16 * mt + 4 * lg + qq) * RP + (16 * et + 4 * pp) * 2));
                acc[et] = __builtin_amdgcn_mfma_f32_16x16x16bf16_1k(vf, P[mt], acc[et], 0, 0, 0); } } }
        {
            float s = 0.f;
#pragma unroll
            for (int et = 0; et < 16; ++et) s += (acc[et][0] + acc[et][1]) + (acc[et][2] + acc[et][3]);
            s += shx<16>(s); s += shx<32>(s);
            const float mean = s * (1.0f / 256.0f); float q = 0.f;
#pragma unroll
            for (int et = 0; et < 16; ++et) { acc[et] = acc[et] - mean; q += (acc[et][0] * acc[et][0] + acc[et][1] * acc[et][1]) + (acc[et][2] * acc[et][2] + acc[et][3] * acc[et][3]); }
            q += shx<16>(q); q += shx<32>(q);
            const float rstd = 1.0f / sqrtf(q * (1.0f / 256.0f) + EPS);
            const size_t tok = (size_t)(tok0 + n); const float rsc = rsl[tok] * 1024.0f;
#pragma unroll
            for (int eb = 0; eb < 4; ++eb) {
                f32x4 gnq[4], kcq[4]; unsigned long long rgq[4];
#pragma unroll
                for (int ee = 0; ee < 4; ++ee) { const int col = h * 256 + 16 * (4 * eb + ee) + 4 * lg;
                    gnq[ee] = *(const f32x4*)(rng + col); rgq[ee] = *(const unsigned long long*)(H + tok * NP + C_RG + col); kcq[ee] = *(const f32x4*)(csl + C_RG + col); }
                unsigned olo[4], ohi[4];
#pragma unroll
                for (int ee = 0; ee < 4; ++ee) { const int et = 4 * eb + ee; const f32x4 gn = gnq[ee], kc = kcq[ee];
                    const unsigned rl = (unsigned)rgq[ee], rh = (unsigned)(rgq[ee] >> 32);
                    const float g0 = pg8::act_apply(lo16(rl) * rsc * kc[0], 1), g1 = pg8::act_apply(hi16(rl) * rsc * kc[1], 1), g2 = pg8::act_apply(lo16(rh) * rsc * kc[2], 1), g3 = pg8::act_apply(hi16(rh) * rsc * kc[3], 1);
                    olo[ee] = pk2(acc[et][0] * rstd * gn[0] * g0, acc[et][1] * rstd * gn[1] * g1); ohi[ee] = pk2(acc[et][2] * rstd * gn[2] * g2, acc[et][3] * rstd * gn[3] * g3); }
#pragma unroll
                for (int ep = 0; ep < 2; ++ep) {
                    const v4u w = swap16_pair(olo[2 * ep], ohi[2 * ep], olo[2 * ep + 1], ohi[2 * ep + 1]);
                    *(v4u*)(Y + tok * BW + h * 256 + 16 * (4 * eb + 2 * ep + (lg & 1)) + 4 * (lg & 2)) = w; } }
        }
        __syncthreads();
    }
}

constexpr int IS_TOK = 8320, IS_BUF = 8 * IS_TOK;
__device__ __forceinline__ void ph_idx_scores(const Args& a, const Ctx& c, int l, int rep = 0) {
    const bf16* H = (const bf16*)(a.ws + WS_H); const bf16* IQP = (const bf16*)(a.ws + WS_IQP); float* SC = (float*)(a.ws + WS_SC);
    unsigned* qhead = (unsigned*)(a.ws + WS_CTL) + CW_QIDX + 64 * (l + 2 * rep);
    volatile LAS unsigned* MISC = (volatile LAS unsigned*)(c.lds + MISC_OFF);
    const int lane = c.lane, w = c.wave, j = lane & 31, hh = lane >> 5;
    constexpr int UPB = 544, NBIG = 2 * UPB - 128;
    if (c.tid == 0) MISC[0] = __hip_atomic_fetch_add(qhead, 1u, __ATOMIC_RELAXED, __HIP_MEMORY_SCOPE_AGENT);
    for (;;) {
        __syncthreads();
        const int U = (int)MISC[0];
        __syncthreads();
        if (U >= NBIG + 4 * (2 * UPB - NBIG)) break;
        unsigned unext = 0u;
        if (c.tid == 0) unext = __hip_atomic_fetch_add(qhead, 1u, __ATOMIC_RELAXED, __HIP_MEMORY_SCOPE_AGENT);
        const int UU = U < NBIG ? U : NBIG + ((U - NBIG) >> 2), g0 = U < NBIG ? 0 : 4 * ((U - NBIG) & 3), g1 = U < NBIG ? 16 : g0 + 4;
        const int b = UU / UPB; int r = UU - b * UPB, tc = 0;
        while (r >= (tc >> 2) + 1) { r -= (tc >> 2) + 1; ++tc; }
        const int kb = r, t0 = 128 * tc, k0 = 512 * kb + 64 * w;
        const bool active = k0 <= t0 + 127;
        bf16x8 kf[2][8];
#pragma unroll
        for (int q = 0; q < 2; ++q) { const bf16* kp = H + (size_t)(b * SEQ + k0 + 32 * q + j) * NP + C_IK + 8 * hh;
#pragma unroll
            for (int ks = 0; ks < 8; ++ks) kf[q][ks] = *(const bf16x8*)(kp + 16 * ks); }
#define IS_STAGE(gi_, bufo_) do { const size_t tok_ = (size_t)(b * SEQ + t0 + 8 * (gi_) + w); const char* src_ = (const char*)(IQP + tok_ * 4096) + lane * 16; \
        _Pragma("unroll") for (int p_ = 0; p_ < 8; ++p_) __builtin_amdgcn_global_load_lds((const unsigned*)(src_ + p_ * 1024), (LAS unsigned*)(c.lds + (bufo_) + w * IS_TOK + p_ * 1024), 16, 0, 0); \
        if (lane < 32) ((LAS float*)(c.lds + (bufo_) + w * IS_TOK + 8192))[lane] = bf2f(H[tok_ * NP + C_IW + lane]) * 0.015625f; } while (0)
#define IS_LOADA(dst_, tk_) do { const LAS unsigned char* tb_ = c.lds + bo + (tk_) * IS_TOK; \
        _Pragma("unroll") for (int ks_ = 0; ks_ < 8; ++ks_) dst_[ks_] = *(const LAS bf16x8*)(tb_ + ks_ * 1024 + lane * 16); } while (0)
#define IS_MMA(src_) do { _Pragma("unroll") for (int i_ = 0; i_ < 16; ++i_) { acc0[i_] = 0.f; acc1[i_] = 0.f; } \
        _Pragma("unroll") for (int ks_ = 0; ks_ < 8; ++ks_) { acc0 = __builtin_amdgcn_mfma_f32_32x32x16_bf16(src_[ks_], kf[0][ks_], acc0, 0, 0, 0); acc1 = __builtin_amdgcn_mfma_f32_32x32x16_bf16(src_[ks_], kf[1][ks_], acc1, 0, 0, 0); } } while (0)
#define IS_EPI(tk_) do { const int t_ = t0 + 8 * gi + (tk_); const LAS unsigned char* tb_ = c.lds + bo + (tk_) * IS_TOK; \
        float s0_ = 0.f, s1_ = 0.f; \
        _Pragma("unroll") for (int g_ = 0; g_ < 4; ++g_) { const f32x4 wq_ = *(const LAS f32x4*)(tb_ + 8192 + (8 * g_ + 4 * hh) * 4); \
            _Pragma("unroll") for (int e_ = 0; e_ < 4; ++e_) { s0_ += wq_[e_] * fmaxf(acc0[4 * g_ + e_], 0.f); s1_ += wq_[e_] * fmaxf(acc1[4 * g_ + e_], 0.f); } } \
        float v_ = hh ? s1_ : s0_; const float o_ = hh ? s0_ : s1_; v_ += shx<32>(o_); \
        if (k0 + lane <= t_) SC[(size_t)(b * SEQ + t_) * SEQ + k0 + lane] = v_; } while (0)
#define IS_TOKEN(tk_) do { bf16x8 af_[8]; f32x16 acc0, acc1; IS_LOADA(af_, tk_); __builtin_amdgcn_sched_barrier(0); IS_MMA(af_); IS_EPI(tk_); } while (0)
#define IS_LOADW(dst_, tk_) do { const LAS unsigned char* tb_ = c.lds + bo + (tk_) * IS_TOK; \
        _Pragma("unroll") for (int g_ = 0; g_ < 4; ++g_) dst_[g_] = *(const LAS f32x4*)(tb_ + 8192 + (8 * g_ + 4 * hh) * 4); } while (0)
#define IS_EPIW(tk_, wq_) do { const int t_ = t0 + 8 * gi + (tk_); float s0_ = 0.f, s1_ = 0.f;     \
        _Pragma("unroll") for (int g_ = 0; g_ < 4; ++g_) { \
            _Pragma("unroll") for (int e_ = 0; e_ < 4; ++e_) { s0_ += wq_[g_][e_] * fmaxf(acc0[4 * g_ + e_], 0.f); s1_ += wq_[g_][e_] * fmaxf(acc1[4 * g_ + e_], 0.f); } } \
        float v_ = hh ? s1_ : s0_; const float o_ = hh ? s0_ : s1_; v_ += shx<32>(o_); \
        SC[(size_t)(b * SEQ + t_) * SEQ + k0 + lane] = v_; } while (0)
        IS_STAGE(g0, (g0 & 1) * IS_BUF);
        VM_WAIT(); LDS_WAIT(); __builtin_amdgcn_s_barrier(); asm volatile("" ::: "memory");
        for (int gi = g0; gi < g1; ++gi) {
            const int bo = (gi & 1) * IS_BUF;
            if (gi + 1 < g1) { const int bn = ((gi + 1) & 1) * IS_BUF; IS_STAGE(gi + 1, bn); }
            if (active) {
                if (k0 + 63 <= t0 + 8 * gi) {
                    bf16x8 afA[8], afB[8]; f32x4 wA[4], wB[4]; f32x16 acc0, acc1;
                    IS_LOADA(afA, 0); IS_LOADW(wA, 0);
#pragma unroll
                    for (int tk = 0; tk < 8; ++tk) {
                        __builtin_amdgcn_sched_barrier(0);
                        if (tk & 1) { IS_MMA(afB); __builtin_amdgcn_sched_barrier(0); if (tk < 7) { IS_LOADA(afA, tk + 1); IS_LOADW(wA, tk + 1); } __builtin_amdgcn_sched_barrier(0); IS_EPIW(tk, wB); }
                        else        { IS_MMA(afA); __builtin_amdgcn_sched_barrier(0); if (tk < 7) { IS_LOADA(afB, tk + 1); IS_LOADW(wB, tk + 1); } __builtin_amdgcn_sched_barrier(0); IS_EPIW(tk, wA); }
                    }
                } else {
                    for (int tk = 0; tk < 8; ++tk) { if (k0 <= t0 + 8 * gi + tk) IS_TOKEN(tk); }
                }
            }
            VM_WAIT(); LDS_WAIT(); asm volatile("" ::: "memory"); __builtin_amdgcn_s_barrier(); asm volatile("" ::: "memory");
        }
        if (c.tid == 0) MISC[0] = unext;
#undef IS_STAGE
#undef IS_TOKEN
#undef IS_LOADA
#undef IS_MMA
#undef IS_EPI
#undef IS_LOADW
#undef IS_EPIW
    }
}

__device__ __forceinline__ unsigned fkey(float f) { const unsigned u = __float_as_uint(f); return (u & 0x80000000u) ? ~u : (u | 0x80000000u); }
__device__ __forceinline__ void topk_row(const float* srow, int n, int* sel, LAS unsigned* hist, int lane) {
    unsigned prefix = 0u; int need = 256;
    for (int pass = 0; pass < 3; ++pass) {
        const int shift = pass == 0 ? 21 : (pass == 1 ? 10 : 0), hshift = pass == 0 ? 31 : (pass == 1 ? 21 : 10);
        const unsigned dmask = pass == 2 ? 1023u : 2047u;
#pragma unroll
        for (int k = 0; k < 8; ++k) *(LAS v4u*)(hist + 4 * (lane + 64 * k)) = (v4u){0u, 0u, 0u, 0u};
        LDS_WAIT();
        v4u kn[4];
#pragma unroll
        for (int j = 0; j < 4; ++j) kn[j] = *(const v4u*)(srow + 256 * j + 4 * lane);
        for (int base = 0; base < n; base += 1024) {
            v4u k4[4];
#pragma unroll
            for (int j = 0; j < 4; ++j) k4[j] = kn[j];
            if (base + 1024 < n) {
#pragma unroll
                for (int j = 0; j < 4; ++j) kn[j] = *(const v4u*)(srow + base + 1024 + 256 * j + 4 * lane); }
#pragma unroll
            for (int j = 0; j < 4; ++j)
#pragma unroll
                for (int e = 0; e < 4; ++e) { const unsigned u = k4[j][e]; const unsigned o = (u & 0x80000000u) ? ~u : (u | 0x80000000u);
                    if (base + 256 * j + 4 * lane + e < n && (pass == 0 || (o >> hshift) == prefix)) __hip_atomic_fetch_add(&hist[(o >> shift) & dmask], 1u, __ATOMIC_RELAXED, __HIP_MEMORY_SCOPE_WORKGROUP); }
        }
        LDS_WAIT();
        unsigned s = 0;
#pragma unroll
        for (int k = 0; k < 8; ++k) { const v4u hv = *(const LAS v4u*)(hist + 2044 - 32 * lane - 4 * k); s += hv.x + hv.y + hv.z + hv.w; }
        unsigned incl = s;
#pragma unroll
        for (int o = 1; o < 64; o <<= 1) { const unsigned tt = sh_up(incl, o); if (lane >= o) incl += tt; }
        const unsigned excl = incl - s;
        const bool mine = (excl < (unsigned)need) && (incl >= (unsigned)need);
        int d = 0, nn = 0;
        if (mine) { unsigned run = excl; bool f = false;
            for (int k = 0; k < 32; ++k) { const unsigned cbk = hist[2047 - 32 * lane - k]; if (!f && run + cbk >= (unsigned)need) { d = 2047 - 32 * lane - k; nn = need - (int)run; f = true; } run += cbk; } }
        const unsigned long long bm = __ballot(mine);
        const int src = (int)__ffsll((long long)bm) - 1;
        d = sh_idx(d, src); nn = sh_idx(nn, src);
        prefix = pass == 2 ? ((prefix << 10) | (unsigned)d) : ((prefix << 11) | (unsigned)d); need = nn;
        LDS_WAIT();
    }
    const unsigned tau = prefix; const int r_eq = need, n_gt = 256 - r_eq;
    int cnt_gt = 0, cnt_eq = 0; const unsigned long long lt = (1ull << lane) - 1ull;
    for (int base = 0; base < n; base += 1024) {
        v4u k4[4];
#pragma unroll
        for (int j = 0; j < 4; ++j) k4[j] = *(const v4u*)(srow + base + 256 * j + 4 * lane);
#pragma unroll
        for (int j = 0; j < 4; ++j)
#pragma unroll
            for (int e = 0; e < 4; ++e) { const unsigned u = k4[j][e]; const unsigned o = (u & 0x80000000u) ? ~u : (u | 0x80000000u); const int i = base + 256 * j + 4 * lane + e;
                const bool valid = i < n, gt = valid && o > tau, eq = valid && o == tau;
                const unsigned long long mg = __ballot(gt), me = __ballot(eq);
                if (gt) sel[cnt_gt + __popcll(mg & lt)] = i;
                if (eq) { const int rk = cnt_eq + __popcll(me & lt); if (rk < r_eq) sel[n_gt + rk] = i; }
                cnt_gt += __popcll(mg); cnt_eq += __popcll(me); }
    }
}
__device__ __forceinline__ void topk_row2(const float* srow, int n, int* sel, LAS unsigned* hist, int lane) {
#pragma unroll
    for (int k = 0; k < 8; ++k) *(LAS v4u*)(hist + 4 * (lane + 64 * k)) = (v4u){0u, 0u, 0u, 0u};
    LDS_WAIT();
    {
        v4u kn[4];
#pragma unroll
        for (int j = 0; j < 4; ++j) kn[j] = *(const v4u*)(srow + 256 * j + 4 * lane);
        for (int base = 0; base < n; base += 1024) {
            v4u k4[4];
#pragma unroll
            for (int j = 0; j < 4; ++j) k4[j] = kn[j];
            if (base + 1024 < n) {
#pragma unroll
                for (int j = 0; j < 4; ++j) kn[j] = *(const v4u*)(srow + base + 1024 + 256 * j + 4 * lane); }
#pragma unroll
            for (int j = 0; j < 4; ++j)
#pragma unroll
                for (int e = 0; e < 4; ++e) { const unsigned u = k4[j][e]; const unsigned o = (u & 0x80000000u) ? ~u : (u | 0x80000000u);
                    if (base + 256 * j + 4 * lane + e < n) __hip_atomic_fetch_add(&hist[o >> 21], 1u, __ATOMIC_RELAXED, __HIP_MEMORY_SCOPE_WORKGROUP); }
        }
    }
    LDS_WAIT();
    int D0, need1, cbin;
    {
        unsigned s = 0;
#pragma unroll
        for (int k = 0; k < 8; ++k) { const v4u hv = *(const LAS v4u*)(hist + 2044 - 32 * lane - 4 * k); s += hv.x + hv.y + hv.z + hv.w; }
        unsigned incl = s;
#pragma unroll
        for (int o = 1; o < 64; o <<= 1) { const unsigned tt = sh_up(incl, o); if (lane >= o) incl += tt; }
        const unsigned excl = incl - s;
        const bool mine = (excl < 256u) && (incl >= 256u);
        int d = 0, nn = 0, cb = 0;
        if (mine) { unsigned run = excl; bool f = false;
            for (int k = 0; k < 32; ++k) { const unsigned cbk = hist[2047 - 32 * lane - k]; if (!f && run + cbk >= 256u) { d = 2047 - 32 * lane - k; nn = 256 - (int)run; cb = (int)cbk; f = true; } run += cbk; } }
        const unsigned long long bm = __ballot(mine);
        const int src = (int)__ffsll((long long)bm) - 1;
        D0 = sh_idx(d, src); need1 = sh_idx(nn, src); cbin = sh_idx(cb, src);
    }
    LDS_WAIT();
    if (cbin > 2048) { topk_row(srow, n, sel, hist, lane); return; }
    LAS unsigned* ckey = hist; LAS unsigned short* cidx = (LAS unsigned short*)(hist + 2048); LAS unsigned* h2 = hist + 3072;
    const unsigned long long lt = (1ull << lane) - 1ull;
    int cnt_gt = 0, cnt_c = 0;
    {
        v4u kn[4];
#pragma unroll
        for (int j = 0; j < 4; ++j) kn[j] = *(const v4u*)(srow + 256 * j + 4 * lane);
        for (int base = 0; base < n; base += 1024) {
            v4u k4[4];
#pragma unroll
            for (int j = 0; j < 4; ++j) k4[j] = kn[j];
            if (base + 1024 < n) {
#pragma unroll
                for (int j = 0; j < 4; ++j) kn[j] = *(const v4u*)(srow + base + 1024 + 256 * j + 4 * lane); }
#pragma unroll
            for (int j = 0; j < 4; ++j)
#pragma unroll
                for (int e = 0; e < 4; ++e) { const unsigned u = k4[j][e]; const unsigned o = (u & 0x80000000u) ? ~u : (u | 0x80000000u); const int i = base + 256 * j + 4 * lane + e;
                    const bool valid = i < n; const int dg = (int)(o >> 21);
                    const bool gt = valid && dg > D0, eq = valid && dg == D0;
                    const unsigned long long mg = __ballot(gt), me = __ballot(eq);
                    if (gt) sel[cnt_gt + __popcll(mg & lt)] = i;
                    if (eq) { const int pos = cnt_c + __popcll(me & lt); ckey[pos] = o & 0x1fffffu; cidx[pos] = (unsigned short)i; }
                    cnt_gt += __popcll(mg); cnt_c += __popcll(me); }
        }
    }
    LDS_WAIT();
    unsigned prefix = 0u; int need = need1;
    for (int pass = 0; pass < 3; ++pass) {
        const int shift = 14 - 7 * pass;
        h2[lane] = 0u; h2[lane + 64] = 0u;
        LDS_WAIT();
        for (int i = lane; i < cnt_c; i += 64) { const unsigned o = ckey[i];
            if (pass == 0 || (o >> (shift + 7)) == prefix) __hip_atomic_fetch_add(&h2[(o >> shift) & 127u], 1u, __ATOMIC_RELAXED, __HIP_MEMORY_SCOPE_WORKGROUP); }
        LDS_WAIT();
        const unsigned c0 = h2[127 - 2 * lane], c1 = h2[126 - 2 * lane], s = c0 + c1;
        unsigned incl = s;
#pragma unroll
        for (int o = 1; o < 64; o <<= 1) { const unsigned tt = sh_up(incl, o); if (lane >= o) incl += tt; }
        const unsigned excl = incl - s;
        const bool mine = (excl < (unsigned)need) && (incl >= (unsigned)need);
        int d = 0, nn = 0;
        if (mine) { if (excl + c0 >= (unsigned)need) { d = 127 - 2 * lane; nn = need - (int)excl; } else { d = 126 - 2 * lane; nn = need - (int)(excl + c0); } }
        const unsigned long long bm = __ballot(mine);
        const int src = (int)__ffsll((long long)bm) - 1;
        d = sh_idx(d, src); nn = sh_idx(nn, src);
        prefix = (prefix << 7) | (unsigned)d; need = nn;
        LDS_WAIT();
    }
    {
        const unsigned tau = prefix; const int r_eq = need, n_gt2 = need1 - r_eq, o0 = 256 - need1;
        int c_gt = 0, c_eq = 0;
        for (int base = 0; base < cnt_c; base += 64) { const int i = base + lane; const bool valid = i < cnt_c;
            const unsigned o = valid ? ckey[i] : 0u; const int id = valid ? (int)cidx[i] : 0;
            const bool gt = valid && o > tau, eq = valid && o == tau;
            const unsigned long long mg = __ballot(gt), me = __ballot(eq);
            if (gt) sel[o0 + c_gt + __popcll(mg & lt)] = id;
            if (eq) { const int rk = c_eq + __popcll(me & lt); if (rk < r_eq) sel[o0 + n_gt2 + rk] = id; }
            c_gt += __popcll(mg); c_eq += __popcll(me); }
    }
    LDS_WAIT();
}
__device__ __forceinline__ void ph_topk(const Args& a, const Ctx& c, int l) {
    const float* SC = (const float*)(a.ws + WS_SC); int* SEL = (int*)(a.ws + WS_SEL);
    LAS unsigned* hist = (LAS unsigned*)(c.lds + c.wave * 16384);
    const int lane = c.lane;
    if ((c.G & 7) == 0) {
        unsigned* ctr = (unsigned*)(a.ws + WS_CTL) + CW_TK + (l * 8 + (c.bx & 7)) * 16;
        unsigned q = 0u;
        if (lane == 0) q = __hip_atomic_fetch_add(ctr, 1u, __ATOMIC_RELAXED, __HIP_MEMORY_SCOPE_AGENT);
        q = (unsigned)__builtin_amdgcn_readfirstlane((int)q);
        while (q < 2048u) {
            unsigned qn = 0u;
            if (lane == 0) qn = __hip_atomic_fetch_add(ctr, 1u, __ATOMIC_RELAXED, __HIP_MEMORY_SCOPE_AGENT);
            const int o = (int)q * 8 + (c.bx & 7), t = SEQ - 1 - (o >> 1), row = (o & 1) * SEQ + t, n = t + 1;
            int* sel = SEL + (size_t)row * 256;
            if (n <= 256) { for (int k = lane; k < 256; k += 64) sel[k] = k < n ? k : -1; }
            else topk_row2(SC + (size_t)row * SEQ, n, sel, hist, lane);
            q = (unsigned)__builtin_amdgcn_readfirstlane((int)qn);
        }
        return;
    }
    const int gw = c.bx * NWAVES + c.wave, NGW = c.G * NWAVES;
    for (int it = gw; it < MTOK; it += NGW) {
        const int u = it & (SEQ - 1), blk = u >> 11, t = (blk & 1) ? (blk << 11) + (2047 - (u & 2047)) : u, row = (it & ~(SEQ - 1)) + t, n = t + 1;
        int* sel = SEL + (size_t)row * 256;
        if (n <= 256) { for (int k = lane; k < 256; k += 64) sel[k] = k < n ? k : -1; }
        else topk_row2(SC + (size_t)row * SEQ, n, sel, hist, lane);
    }
}

__device__ __forceinline__ void ph_dsa_attn(const Args& a, const Ctx& c, int l) {
    const bf16* H = (const bf16*)(a.ws + WS_H); const int* SEL = (const int*)(a.ws + WS_SEL); bf16* Y = (bf16*)(a.ws + WS_Y) + (size_t)MTOK * BW;
    const float* rsl = (const float*)(a.ws + WS_RSC) + (size_t)l * MTOK; const float* csl = (const float*)(a.ws + WS_RSC) + DEPTH * MTOK + l * NP;
    LAS unsigned char* buf = c.lds + c.wave * 18432;
    const int gw = c.bx * NWAVES + c.wave, NGW = c.G * NWAVES, lane = c.lane, cc = lane & 15, g = lane >> 4, jm = cc >> 2;
    int seln[4]; v4u qn[4];
    if (gw < MTOK) {
#pragma unroll
        for (int i = 0; i < 4; ++i) seln[i] = SEL[(size_t)gw * 256 + lane + 64 * i];
#pragma unroll
        for (int ks = 0; ks < 4; ++ks) qn[ks] = *(const v4u*)(H + (size_t)gw * NP + C_DQ + cc * 128 + 32 * ks + 8 * g); }
    for (int row = gw; row < MTOK; row += NGW) {
        const int b = row >> 13, n = (row & (SEQ - 1)) + 1;
        unsigned seli[4];
#pragma unroll
        for (int i = 0; i < 4; ++i) seli[i] = (unsigned)(seln[i] < 0 ? 0 : seln[i]);
        const bf16* hq = H + (size_t)row * NP;
        long qf8[4];
#pragma unroll
        for (int ks = 0; ks < 4; ++ks) { float qv[8]; unpack8(qn[ks], qv); qf8[ks] = (long)pack8_fp8(qv); }
        const char* k8b = (const char*)(a.ws + WS_K8) + (size_t)b * SEQ * 512;
        const char* v8b = (const char*)(a.ws + WS_V8) + (size_t)b * SEQ * 512;
#define DSA_KDMA(kt_, bsel_) do { unsigned sv_ = seli[(kt_) >> 2]; asm volatile("" : "+v"(sv_)); \
        _Pragma("unroll") for (int p_ = 0; p_ < 8; ++p_) { const unsigned sa_ = (unsigned)__builtin_amdgcn_readlane((int)sv_, ((kt_) & 3) * 16 + 2 * p_) << 9, sb_ = (unsigned)__builtin_amdgcn_readlane((int)sv_, ((kt_) & 3) * 16 + 2 * p_ + 1) << 9; \
            const unsigned rr_ = 2u * p_ + (unsigned)(lane >> 5), off_ = (lane < 32 ? sa_ : sb_) + ((((unsigned)lane & 31u) ^ rr_) << 4); \
            __builtin_amdgcn_global_load_lds((const unsigned*)(k8b + (size_t)off_), (LAS unsigned*)(buf + (bsel_) * 8192 + p_ * 1024), 16, 0, 0); } } while (0)
        f32x4 S[16];
        DSA_KDMA(0, 0); DSA_KDMA(1, 1);
#pragma unroll
        for (int kt = 0; kt < 16; ++kt) {
            if (kt < 15) asm volatile("s_waitcnt vmcnt(8)" ::: "memory"); else asm volatile("s_waitcnt vmcnt(0)" ::: "memory");
            f32x4 sacc = {0.f, 0.f, 0.f, 0.f};
#pragma unroll
            for (int j = 0; j < 4; ++j) { long A[4]; f32x4 acc = {0.f, 0.f, 0.f, 0.f};
#pragma unroll
                for (int ks = 0; ks < 4; ++ks) A[ks] = *(const LAS long*)(buf + (kt & 1) * 8192 + cc * 512 + ((((unsigned)(8 * j + 2 * ks + (g >> 1))) ^ (unsigned)cc) << 4) + 8 * (g & 1));
#pragma unroll
                for (int ks = 0; ks < 4; ++ks) acc = __builtin_amdgcn_mfma_f32_16x16x32_fp8_fp8(A[ks], qf8[ks], acc, 0, 0, 0);
                sacc = (jm == j) ? acc : sacc; }
            asm volatile("s_waitcnt lgkmcnt(0)" ::: "memory");
            __builtin_amdgcn_sched_barrier(0);
            if (kt + 2 < 16) DSA_KDMA(kt + 2, kt & 1);
            S[kt] = sacc;
            __builtin_amdgcn_sched_barrier(0);
        }
#undef DSA_KDMA
        float mx = -INFINITY;
        int nt = n - 4 * g; asm volatile("" : "+v"(nt));
#pragma unroll
        for (int kt = 0; kt < 16; ++kt)
#pragma unroll
            for (int e = 0; e < 4; ++e) { float v = S[kt][e] * 0.08838834764831845f; if (16 * kt + e >= nt) v = -INFINITY; S[kt][e] = v; mx = fmaxf(mx, v); }
        mx = fmaxf(mx, shx<16>(mx)); mx = fmaxf(mx, shx<32>(mx));
        float sum = 0.f;
#pragma unroll
        for (int kt = 0; kt < 16; ++kt)
#pragma unroll
            for (int e = 0; e < 4; ++e) { const float pv = __expf(S[kt][e] - mx + 5.545177444479562f); S[kt][e] = pv; sum += pv; }
        sum += shx<16>(sum); sum += shx<32>(sum);
        f32x4 O[8];
#pragma unroll
        for (int dt = 0; dt < 8; ++dt) O[dt] = (f32x4){0.f, 0.f, 0.f, 0.f};
        const unsigned li = (unsigned)lane & 15u, tq = li >> 1, rho = 16u * ((unsigned)g >> 1) + 8u * (tq >> 2) + 4u * ((unsigned)g & 1u) + (tq & 3u);
        const unsigned vrd = (unsigned)(c.wave * 18432) + rho * 512u + 8u * (li & 1u) + ((rho & 15u) << 4);
#pragma unroll
        for (int t = 0; t < 8; ++t) {
            unsigned sv = seli[t >> 1]; asm volatile("" : "+v"(sv));
#pragma unroll
            for (int p_ = 0; p_ < 16; ++p_) {
                const int ra = 2 * p_, rb = 2 * p_ + 1, ka = 16 * ((ra >> 3) & 1) + 8 * (ra >> 4) + (ra & 7), kb2 = 16 * ((rb >> 3) & 1) + 8 * (rb >> 4) + (rb & 7);
                const unsigned sa = (unsigned)__builtin_amdgcn_readlane((int)sv, (t & 1) * 32 + ka) << 9, sb = (unsigned)__builtin_amdgcn_readlane((int)sv, (t & 1) * 32 + kb2) << 9;
                const unsigned rr = 2u * p_ + (unsigned)(lane >> 5), off = (lane < 32 ? sa : sb) + ((((unsigned)lane & 31u) ^ (rr & 15u)) << 4);
                __builtin_amdgcn_global_load_lds((const unsigned*)(v8b + (size_t)off), (LAS unsigned*)(buf + p_ * 1024), 16, 0, 0); }
            asm volatile("s_waitcnt vmcnt(0)" ::: "memory");
            int w0 = __builtin_amdgcn_cvt_pk_fp8_f32(S[2 * t][0], S[2 * t][1], 0, false); w0 = __builtin_amdgcn_cvt_pk_fp8_f32(S[2 * t][2], S[2 * t][3], w0, true);
            int w1 = __builtin_amdgcn_cvt_pk_fp8_f32(S[2 * t + 1][0], S[2 * t + 1][1], 0, false); w1 = __builtin_amdgcn_cvt_pk_fp8_f32(S[2 * t + 1][2], S[2 * t + 1][3], w1, true);
            const long pw = (long)((unsigned long long)(unsigned)w0 | ((unsigned long long)(unsigned)w1 << 32));
#pragma unroll
            for (int j = 0; j < 4; ++j) { const long Bj = ((cc >> 2) == j) ? pw : 0L;
                unsigned va = vrd; asm volatile("" : "+v"(va));
#pragma unroll
                for (int dt = 0; dt < 8; ++dt) { typedef int v2i __attribute__((ext_vector_type(2)));
                    const v2i av = __builtin_amdgcn_ds_read_tr8_b64_v2i32((LAS v2i*)(c.lds + (va ^ (unsigned)((8 * (j & 1) + dt) << 4)) + 256 * (j >> 1)));
                    O[dt] = __builtin_amdgcn_mfma_f32_16x16x32_fp8_fp8(__builtin_bit_cast(long, av), Bj, O[dt], 0, 0, 0); }
                __builtin_amdgcn_sched_barrier(0); }
            asm volatile("s_waitcnt lgkmcnt(0)" ::: "memory");
        }
        __builtin_amdgcn_sched_barrier(0);
        const float inv = 1.0f / sum, rsc = rsl[row] * 1024.0f;
        { const int rnx = (row + NGW < MTOK) ? row + NGW : row;
#pragma unroll
          for (int i = 0; i < 4; ++i) seln[i] = SEL[(size_t)rnx * 256 + lane + 64 * i];
#pragma unroll
          for (int ks = 0; ks < 4; ++ks) qn[ks] = *(const v4u*)(H + (size_t)rnx * NP + C_DQ + cc * 128 + 32 * ks + 8 * g); }
        unsigned long long gdq[8]; f32x4 kcq[8];
#pragma unroll
        for (int dt = 0; dt < 8; ++dt) { const int col = cc * 128 + 16 * dt + 4 * g; gdq[dt] = *(const unsigned long long*)(hq + C_DG + col); kcq[dt] = *(const f32x4*)(csl + C_DG + col); }
        unsigned olo[8], ohi[8];
#pragma unroll
        for (int dt = 0; dt < 8; ++dt) {
            const unsigned gl = (unsigned)gdq[dt], gh = (unsigned)(gdq[dt] >> 32); const f32x4 kc = kcq[dt];
            const float g0 = pg8::act_apply(lo16(gl) * rsc * kc[0], 1), g1 = pg8::act_apply(hi16(gl) * rsc * kc[1], 1), g2 = pg8::act_apply(lo16(gh) * rsc * kc[2], 1), g3 = pg8::act_apply(hi16(gh) * rsc * kc[3], 1);
            olo[dt] = pk2(O[dt][0] * inv * g0, O[dt][1] * inv * g1); ohi[dt] = pk2(O[dt][2] * inv * g2, O[dt][3] * inv * g3); }
#pragma unroll
        for (int dp = 0; dp < 4; ++dp) {
            const v4u w = swap16_pair(olo[2 * dp], ohi[2 * dp], olo[2 * dp + 1], ohi[2 * dp + 1]);
            *(v4u*)(Y + (size_t)row * BW + cc * 128 + 16 * (2 * dp + (g & 1)) + 4 * (g & 2)) = w; }
    }
}

__device__ __forceinline__ void ph_gmlp(const Args& a, const Ctx& c, int l, int u0, int ustep) {
    const bf16* H = (const bf16*)(a.ws + WS_H); const float* GVS = (const float*)(a.ws + WS_GVS); bf16* Y = (bf16*)(a.ws + WS_Y) + (size_t)2 * MTOK * BW;
    const float* gmg = a.in[IN_GMG] + l * BW; const bf16* WSB = (const bf16*)(a.ws + WS_WSB) + (size_t)l * 16 * 128 * 128; const float* bsp = a.in[IN_BS] + l * 16 * 128;
    const float* rsl = (const float*)(a.ws + WS_RSC) + (size_t)l * MTOK; const float* csl = (const float*)(a.ws + WS_RSC) + DEPTH * MTOK + l * NP;
    constexpr int GP = 272;
    const int lane = c.lane, w = c.wave, tl = lane & 15, lg = lane >> 4, qq = (lane & 15) >> 2, pp = lane & 3;
    for (int u = u0; u < 2048; u += ustep) {
        const int b = u >> 10, nck = (u >> 4) & 63, g = u & 15, tok0 = b * SEQ + nck * 128;
#pragma unroll
        for (int i = 0; i < 4; ++i) { const int id = c.tid + 512 * i, s = id >> 4, ch = id & 15; const size_t tok = (size_t)(tok0 + s);
            const v4u x = *(const v4u*)(H + tok * NP + C_GV + g * 128 + 8 * ch); const float mean = GVS[2 * tok], rstd = GVS[2 * tok + 1];
            const f32x4 g0 = *(const f32x4*)(gmg + g * 128 + 8 * ch), g1 = *(const f32x4*)(gmg + g * 128 + 8 * ch + 4);
            v4u o; o.x = pk2((lo16(x.x) - mean) * rstd * g0[0], (hi16(x.x) - mean) * rstd * g0[1]); o.y = pk2((lo16(x.y) - mean) * rstd * g0[2], (hi16(x.y) - mean) * rstd * g0[3]);
            o.z = pk2((lo16(x.z) - mean) * rstd * g1[0], (hi16(x.z) - mean) * rstd * g1[1]); o.w = pk2((lo16(x.w) - mean) * rstd * g1[2], (hi16(x.w) - mean) * rstd * g1[3]);
            *(LAS v4u*)(c.lds + s * GP + ch * 16) = o; }
        bf16x8 wfq[4];
#pragma unroll
        for (int ks = 0; ks < 4; ++ks) wfq[ks] = *(const bf16x8*)(WSB + (size_t)(g * 128 + 16 * w + tl) * 128 + 32 * ks + 8 * lg);
        __syncthreads();
        f32x4 acc[8];
#pragma unroll
        for (int ct = 0; ct < 8; ++ct) acc[ct] = (f32x4){0.f, 0.f, 0.f, 0.f};
        const int nks = (w >> 1) + 1;
#pragma unroll
        for (int ks = 0; ks < 4; ++ks) { if (ks < nks) {
            const bf16x8 wf = wfq[ks];
#pragma unroll
            for (int ct = 0; ct < 8; ++ct) {
                const s16x4 v0 = __builtin_amdgcn_ds_read_tr16_b64_v4i16((LAS s16x4*)(c.lds + (32 * ks + 8 * lg + qq) * GP + (16 * ct + 4 * pp) * 2));
                const s16x4 v1 = __builtin_amdgcn_ds_read_tr16_b64_v4i16((LAS s16x4*)(c.lds + (32 * ks + 8 * lg + 4 + qq) * GP + (16 * ct + 4 * pp) * 2));
                const bf16x8 vf = {v0[0], v0[1], v0[2], v0[3], v1[0], v1[1], v1[2], v1[3]};
                acc[ct] = __builtin_amdgcn_mfma_f32_16x16x32_bf16(vf, wf, acc[ct], 0, 0, 0); }
        } }
        {
            const int t = 16 * w + tl; const size_t tok = (size_t)(tok0 + t); const float bias = bsp[g * 128 + t], rsc = rsl[tok] * 1024.0f;
            unsigned long long guq[8], ggq[8]; f32x4 kuq[8], kgq[8];
#pragma unroll
            for (int ct = 0; ct < 8; ++ct) { const int col = g * 128 + 16 * ct + 4 * lg;
                guq[ct] = *(const unsigned long long*)(H + tok * NP + C_GU + col); ggq[ct] = *(const unsigned long long*)(H + tok * NP + C_GG + col);
                kuq[ct] = *(const f32x4*)(csl + C_GU + col); kgq[ct] = *(const f32x4*)(csl + C_GG + col); }
            unsigned olo[8], ohi[8];
#pragma unroll
            for (int ct = 0; ct < 8; ++ct) {
                const unsigned long long gu = guq[ct], gg = ggq[ct];
                const unsigned ul = (unsigned)gu, uh = (unsigned)(gu >> 32), gl = (unsigned)gg, gh = (unsigned)(gg >> 32);
                const f32x4 ku = kuq[ct], kg = kgq[ct];
                const float u0 = pg8::act_apply(lo16(ul) * rsc * ku[0], 2), u1 = pg8::act_apply(hi16(ul) * rsc * ku[1], 2), u2 = pg8::act_apply(lo16(uh) * rsc * ku[2], 2), u3 = pg8::act_apply(hi16(uh) * rsc * ku[3], 2);
                const float g0 = pg8::act_apply(lo16(gl) * rsc * kg[0], 1), g1 = pg8::act_apply(hi16(gl) * rsc * kg[1], 1), g2 = pg8::act_apply(lo16(gh) * rsc * kg[2], 1), g3 = pg8::act_apply(hi16(gh) * rsc * kg[3], 1);
                olo[ct] = pk2(u0 * (acc[ct][0] + bias) * g0, u1 * (acc[ct][1] + bias) * g1); ohi[ct] = pk2(u2 * (acc[ct][2] + bias) * g2, u3 * (acc[ct][3] + bias) * g3); }
#pragma unroll
            for (int cp = 0; cp < 4; ++cp) {
                const v4u w = swap16_pair(olo[2 * cp], ohi[2 * cp], olo[2 * cp + 1], ohi[2 * cp + 1]);
                *(v4u*)(Y + tok * BW + g * 128 + 16 * (2 * cp + (lg & 1)) + 4 * (lg & 2)) = w; }
        }
        __syncthreads();
    }
}

#ifndef G1_ORDER
#define G1_ORDER StaticOrder
#endif
#ifndef G1_ALIGN
#define G1_ALIGN true
#endif
#ifndef G1_SP2
#define G1_SP2 true
#endif
#ifndef REPM
#define REPM 0
#endif
#define NREP(bit) ((REPM & (bit)) ? 2 : 1)
#ifndef PHM
#define PHM 0xffff
#endif
__global__ void __launch_bounds__(NWAVES * 64, 2) mk_fwd(Args args) {
    extern __shared__ __attribute__((aligned(16))) unsigned char lds_raw[];
    Ctx c; c.lds = (LAS unsigned char*)lds_raw; c.tid = threadIdx.x; c.lane = c.tid & 63; c.wave = __builtin_amdgcn_readfirstlane(c.tid >> 6); c.G = gridDim.x; c.bx = blockIdx.x;
#define FRESH() do { int t_ = threadIdx.x; asm volatile("" : "+v"(t_)); c.tid = t_; c.lane = t_ & 63; c.wave = __builtin_amdgcn_readfirstlane(t_ >> 6); } while (0)
    volatile LAS unsigned* MISC = (volatile LAS unsigned*)(c.lds + MISC_OFF);
    if (c.tid < 64) MISC[c.tid] = 0u;
    __syncthreads();
    unsigned* ctl = (unsigned*)(args.ws + WS_CTL);
#if MK_PER_PHASE
    XcdBarrier bar; bar.bar = ctl + CW_BAR; bar.x = 0; bar.st = nullptr;
#define GRID_BAR() do { } while (0)
#else
    XcdBarrier bar = xcd_barrier_post(ctl + CW_BAR, MISC + 8);
#define GRID_BAR() xcd_barrier(bar)
#endif
    const int lo = args.ph_lo, hi = args.ph_hi;
#define IN(k) (lo <= (k) && (k) < hi)
#define SEAM(k) do { if (IN(k) && IN((k) + 1)) GRID_BAR(); } while (0)
    bf16* const H = (bf16*)(args.ws + WS_H);
    if (IN(0)) { if (PHM & 1) for (int rep = 0; rep < NREP(1); ++rep) { FRESH(); ph_prologue(args, c); } if (PHM & 2) { FRESH(); ph_norm(args, c, 0); } } SEAM(0);
    for (int l = 0; l < DEPTH; ++l) {
        const int p0 = 1 + 8 * l;
        if (l > 0) { if (IN(p0 + 0)) { if (PHM & 2) for (int rep = 0; rep < NREP(2); ++rep) { FRESH(); ph_norm(args, c, l); } } SEAM(p0 + 0); }
        if (IN(p0 + 1) && (PHM & 4)) for (int rep = 0; rep < NREP(4); ++rep) {
            pg8::Gemm g{(const bf16*)(args.ws + WS_XQ), (const bf16*)(args.ws + WS_WQ + (size_t)l * WQ_BYTES), MTOK, NP, DM / 2};
            pg8::StaticOrder S; S.init(MTOK, NP, c.G, c.bx); pg8::EpiGate E{H, NP};
            pg8::gemm_phase<pg8::EpiGate, pg8::StaticOrder, true, true, 1>(c.lds, g, S, E);
        } SEAM(p0 + 1);
        if (IN(p0 + 2)) { if (PHM & 8) { FRESH(); ph_prep(args, c, l); } } SEAM(p0 + 2);
        if (IN(p0 + 3)) {
            const bool split = (c.G & 31) == 0; const bool memrole = !split || ((c.bx >> 3) & 3) == 0;
            const int mu0 = split ? (c.bx & 7) + 8 * (c.bx >> 5) : c.bx, mus = split ? c.G >> 2 : c.G;
            if (memrole) { if (PHM & 16) for (int rep = 0; rep < NREP(16); ++rep) { FRESH(); ph_ret_kv(args, c, l, mu0, mus); } if (PHM & 64) for (int rep = 0; rep < NREP(64); ++rep) { FRESH(); ph_gmlp(args, c, l, mu0, mus); } }
            if (PHM & 32) for (int rep = 0; rep < NREP(32); ++rep) { FRESH(); ph_idx_scores(args, c, l, rep); } } SEAM(p0 + 3);
        if (IN(p0 + 4)) {
            const bool split = (c.G & 31) == 0; const bool memrole = !split || ((c.bx >> 3) & 3) == 0;
            if (memrole) { if (PHM & 128) for (int rep = 0; rep < NREP(128); ++rep) { FRESH(); ph_ret_scan(args, c, split ? (c.bx & 7) + 8 * (c.bx >> 5) : c.bx, split ? c.G >> 2 : c.G); } }
            if (PHM & 256) { FRESH(); ph_topk(args, c, l); } } SEAM(p0 + 4);
        if (IN(p0 + 5)) { if (PHM & 512) for (int rep = 0; rep < NREP(512); ++rep) { FRESH(); ph_ret_out(args, c, l); } if (PHM & 1024) for (int rep = 0; rep < NREP(1024); ++rep) { FRESH(); ph_dsa_attn(args, c, l); } } SEAM(p0 + 5);
        if (IN(p0 + 6) && (PHM & 2048)) for (int rep = 0; rep < NREP(2048); ++rep) {
            const bf16* Y = (const bf16*)(args.ws + WS_Y); const bf16* WB = (const bf16*)(args.ws + WS_WBR + (size_t)l * 3 * WBR_BYTES);
            bf16* MB = (bf16*)(args.ws + WS_MB);
            const float* rsl = (const float*)(args.ws + WS_RSC) + (size_t)l * MTOK; const float* csl = (const float*)(args.ws + WS_RSC) + DEPTH * MTOK + l * NP;
            pg8::StaticOrder S; S.init(MTOK, DM, c.G, c.bx);
            { pg8::Gemm g{Y, WB, MTOK, DM, BW}; pg8::EpiMerge<0> E{H + C_MG, NP, MB, DM, rsl, csl + C_MG}; pg8::gemm_phase<pg8::EpiMerge<0>, pg8::StaticOrder, true, true>(c.lds, g, S, E); }
            { pg8::Gemm g{Y + (size_t)MTOK * BW, WB + (size_t)DM * BW, MTOK, DM, BW}; pg8::EpiMerge<1> E{H + C_MG + DM, NP, MB, DM, rsl, csl + C_MG + DM}; pg8::gemm_phase<pg8::EpiMerge<1>, pg8::StaticOrder, true, true>(c.lds, g, S, E); }
            { pg8::Gemm g{Y + (size_t)2 * MTOK * BW, WB + (size_t)2 * DM * BW, MTOK, DM, BW}; pg8::EpiMerge<2> E{H + C_MG + 2 * DM, NP, MB, DM, rsl, csl + C_MG + 2 * DM}; pg8::gemm_phase<pg8::EpiMerge<2>, pg8::StaticOrder, true, true>(c.lds, g, S, E); }
        } SEAM(p0 + 6);
        if (IN(p0 + 7) && (PHM & 4096)) for (int rep = 0; rep < NREP(4096); ++rep) {
            pg8::Gemm g{(const bf16*)(args.ws + WS_MB), (const bf16*)(args.ws + WS_WOUT + (size_t)l * WOUT_BYTES), MTOK, DM, DM};
            pg8::StaticOrder S; S.init(MTOK, DM, c.G, c.bx);
            pg8::EpiRes E{(l == 0) ? args.in[IN_X] : (const float*)(args.ws + WS_X1), (l == DEPTH - 1) ? args.out : (float*)(args.ws + WS_X1), DM};
            pg8::gemm_phase<pg8::EpiRes, pg8::StaticOrder, true, true>(c.lds, g, S, E);
        } SEAM(p0 + 7);
    }
#undef IN
#undef SEAM
}

extern "C" void kernel_launch(void* const* d_in, const int* in_sizes, int n_in, void* d_out, int out_size, void* d_ws, size_t ws_size, hipStream_t stream) {
    static int grid = 0;
    if (grid == 0) {
        if (n_in != 12 || out_size != MTOK * DM || ws_size < WS_END) { fprintf(stderr, "kernel_launch: unexpected shapes (n_in %d out %d ws %zu need %zu)\n", n_in, out_size, ws_size, (size_t)WS_END); grid = -1; return; }
        int dev = 0, cus = 0, per_cu = 0;
        if (hipGetDevice(&dev) != hipSuccess || hipDeviceGetAttribute(&cus, hipDeviceAttributeMultiprocessorCount, dev) != hipSuccess) { grid = -1; return; }
        if (hipFuncSetAttribute((const void*)mk_fwd, hipFuncAttributeMaxDynamicSharedMemorySize, LDS_BYTES) != hipSuccess) { fprintf(stderr, "kernel_launch: hipFuncSetAttribute failed\n"); grid = -1; return; }
        if (hipOccupancyMaxActiveBlocksPerMultiprocessor(&per_cu, (const void*)mk_fwd, NWAVES * 64, LDS_BYTES) != hipSuccess || per_cu < 1) fprintf(stderr, "kernel_launch: occupancy query reports %d\n", per_cu);
        (void)hipGetLastError();
        grid = cus;
    }
    if (grid < 0) return;
    if (hipMemsetAsync((char*)d_ws + WS_CTL, 0, CTL_ZERO_BYTES, stream) != hipSuccess) { fprintf(stderr, "kernel_launch: memset failed\n"); return; }
    Args a{};
    for (int i = 0; i < 12; ++i) a.in[i] = (const float*)d_in[i];
    a.out = (float*)d_out; a.ws = (unsigned char*)d_ws;
#if MK_PER_PHASE
    for (int p = 0; p < NPHASE; ++p) { a.ph_lo = p; a.ph_hi = p + 1; hipLaunchKernelGGL(mk_fwd, dim3(grid), dim3(NWAVES * 64), LDS_BYTES, stream, a); }
#else
    a.ph_lo = 0; a.ph_hi = NPHASE;
    hipLaunchKernelGGL(mk_fwd, dim3(grid), dim3(NWAVES * 64), LDS_BYTES, stream, a);
#endif
    const hipError_t le = hipPeekAtLastError();
    if (le != hipSuccess) fprintf(stderr, "kernel_launch: launch failed: %s\n", hipGetErrorName(le));
}
```

```cpp
#include <hip/hip_runtime.h>
#include <cstdio>
#include <cstdint>
#ifndef PG8_WGM
#define PG8_WGM 8
#endif
namespace pg8 {
#define PG8_LAS __attribute__((address_space(3)))
typedef unsigned short bf16_t;
typedef short bf16x8 __attribute__((ext_vector_type(8)));
typedef float f32x4 __attribute__((ext_vector_type(4)));
typedef unsigned u32x4 __attribute__((ext_vector_type(4)));
constexpr int BM = 256, BK = 64, HALF = 128, HTB = HALF * BK * 2  , STAGE_BYTES = 8 * HTB, NXCD = 8, WGM = PG8_WGM;

__host__ __device__ __forceinline__ int lds_byte(int r, int c) { const int st = (r >> 4) * 2 + (c >> 5), rr = r & 15, cc = c & 31, ob = rr * 64 + cc * 2; return st * 1024 + (ob ^ (((ob >> 9) & 1) << 5)); }
__host__ __device__ __forceinline__ void stage_rc(int b, int& R, int& C) { const int st = b / 1024, sb = b % 1024, swz = sb ^ (((sb >> 9) & 1) << 5); R = (st >> 1) * 16 + swz / 64; C = (st & 1) * 32 + (swz % 64) / 2; }
__host__ __device__ __forceinline__ int perm32(int rho) { const int n = rho >> 4, i = rho & 15; return 8 * (i >> 2) + 4 * n + (i & 3); }

struct Unit { int pm, pn; };
struct Gemm { const bf16_t* A; const bf16_t* Bt; int M, N, K; int ld = 0; };

struct StaticOrder {
    int nM, nN, nwg, G, c, limit;
    __host__ __device__ void init(int M, int N, int G_, int c_) { nM = M / BM; nN = N / BM; nwg = nM * nN; G = G_; c = c_; limit = nwg; }
    __host__ __device__ void unit_of(int L, Unit& u) const {
        int wgid = L; { const int q = nwg / NXCD, r = nwg % NXCD, xcd = wgid % NXCD, off = wgid / NXCD; wgid = (xcd < r ? xcd * (q + 1) : r * (q + 1) + (xcd - r) * q) + off; }
        const int nig = WGM * nN, gid = wgid / nig, fm = gid * WGM, gsz = (nM - fm) < WGM ? (nM - fm) : WGM;
        u.pm = fm + ((wgid % nig) % gsz); u.pn = (wgid % nig) / gsz; }
    __host__ __device__ bool next(int i, Unit& u) const {
        const long L = (long)i * G + c; if (L >= limit) return false;
        int wgid = (int)L; { const int q = nwg / NXCD, r = nwg % NXCD, xcd = wgid % NXCD, off = wgid / NXCD; wgid = (xcd < r ? xcd * (q + 1) : r * (q + 1) + (xcd - r) * q) + off; }
        const int nig = WGM * nN, gid = wgid / nig, fm = gid * WGM, gsz = (nM - fm) < WGM ? (nM - fm) : WGM;
        u.pm = fm + ((wgid % nig) % gsz); u.pn = (wgid % nig) / gsz; return true;
    }
    __device__ __forceinline__ void a_ready(const Unit&) const {}
    __device__ __forceinline__ void done(const Unit&) const {}
};

struct OneUnit {
    StaticOrder base; int L;
    __device__ __forceinline__ bool next(int i, Unit& u) const { if (i > 0 || L >= base.nwg) return false; base.unit_of(L, u); return true; }
    __device__ __forceinline__ void a_ready(const Unit&) const {}
    __device__ __forceinline__ void done(const Unit&) const {}
};
struct SplitOrder {
    StaticOrder base; int first, c;
    __device__ __forceinline__ bool next(int i, Unit& u) const { if (i > 0) return false; base.unit_of(first + (c >> 2), u); return true; }
    __device__ __forceinline__ void a_ready(const Unit&) const {}
    __device__ __forceinline__ void done(const Unit&) const {}
};
struct StaticOrderN {
    int nM, nN, nwg, G, c;
    __host__ __device__ void init(int M, int N, int G_, int c_) { nM = M / BM; nN = N / BM; nwg = nM * nN; G = G_; c = c_; }
    __host__ __device__ bool next(int i, Unit& u) const {
        const long L = (long)i * G + c; if (L >= nwg) return false;
        int wgid = (int)L; { const int q = nwg / NXCD, r = nwg % NXCD, xcd = wgid % NXCD, off = wgid / NXCD; wgid = (xcd < r ? xcd * (q + 1) : r * (q + 1) + (xcd - r) * q) + off; }
        const int nig = WGM * nM, gid = wgid / nig, fn = gid * WGM, gsz = (nN - fn) < WGM ? (nN - fn) : WGM;
        u.pn = fn + ((wgid % nig) % gsz); u.pm = (wgid % nig) / gsz; return true;
    }
    __device__ __forceinline__ void a_ready(const Unit&) const {}
    __device__ __forceinline__ void done(const Unit&) const {}
};

__device__ __forceinline__ unsigned cvt_pk_bf16(float lo, float hi) { unsigned r; asm volatile("v_cvt_pk_bf16_f32 %0, %1, %2" : "=v"(r) : "v"(lo), "v"(hi)); return r; }
typedef float f32x2 __attribute__((ext_vector_type(2)));
typedef int i32x4 __attribute__((ext_vector_type(4)));
template <int DT> __device__ __forceinline__ f32x4 mma16(const bf16x8 a, const bf16x8 b, const f32x4 c) {
    if constexpr (DT == 0) return __builtin_amdgcn_mfma_f32_16x16x32_bf16(a, b, c, 0, 0, 0);
    else return __builtin_bit_cast(f32x4, __builtin_amdgcn_mfma_i32_16x16x64_i8(__builtin_bit_cast(i32x4, a), __builtin_bit_cast(i32x4, b), __builtin_bit_cast(i32x4, c), 0, 0, 0));
}
__device__ __forceinline__ float act_apply(float x, int act) {
    float u = x;
    if (act == 2) u = 1.5957691216057308f * (x + 0.044715f * x * x * x);
    const float s = __builtin_amdgcn_rcpf(1.0f + __builtin_amdgcn_exp2f(-1.4426950408889634f * u));
    return act == 3 ? s : x * s;
}
__device__ __forceinline__ int act_of_tile(int pn) { return (pn >= 93) ? 3 : (pn >= 85) ? 1 : (pn >= 69) ? 2 : (pn >= 61) ? 1 : (pn >= 32) ? 0 : (pn >= 24) ? 1 : 0; }
struct EpiH {
    static constexpr bool PERM = true, AFTER_DRAIN = false;
    bf16_t* O; int ldc; int pn0 = 0;
    __device__ __forceinline__ void operator()(const f32x4 (&acc)[2][2][4][2], const Unit& u, int wr, int wc, int fr, int fq) const {
        const int act = act_of_tile(u.pn + pn0);
        const int row0 = u.pm * BM + wr * 64 + fr, col0 = (u.pn + pn0) * BM + wc * 32 + 8 * fq;
#pragma unroll
        for (int ai = 0; ai < 2; ++ai)
#pragma unroll
            for (int m = 0; m < 4; ++m) { bf16_t* rowp = O + (size_t)(row0 + ai * HALF + m * 16) * ldc + col0;
#pragma unroll
                for (int bj = 0; bj < 2; ++bj) { f32x4 v0 = acc[ai][bj][m][0], v1 = acc[ai][bj][m][1];
                    if (act != 0) {
#pragma unroll
                        for (int j = 0; j < 4; ++j) { v0[j] = act_apply(v0[j], act); v1[j] = act_apply(v1[j], act); } }
                    u32x4 w; w.x = cvt_pk_bf16(v0[0], v0[1]); w.y = cvt_pk_bf16(v0[2], v0[3]); w.z = cvt_pk_bf16(v1[0], v1[1]); w.w = cvt_pk_bf16(v1[2], v1[3]);
                    *(u32x4*)(rowp + bj * HALF) = w; } }
    }
};
template <int MODE> struct EpiMerge {
    static constexpr bool PERM = true, AFTER_DRAIN = false;
    const bf16_t* gate; int ldg; bf16_t* Mb; int ldc; const float* rs; const float* cs;
    __device__ __forceinline__ void operator()(const f32x4 (&acc)[2][2][4][2], const Unit& u, int wr, int wc, int fr, int fq) const {
        const int row0 = u.pm * BM + wr * 64 + fr, col0 = u.pn * BM + wc * 32 + 8 * fq;
        f32x4 k0[2], k1[2];
#pragma unroll
        for (int bj = 0; bj < 2; ++bj) { k0[bj] = *(const f32x4*)(cs + col0 + bj * HALF); k1[bj] = *(const f32x4*)(cs + col0 + bj * HALF + 4); }
#pragma unroll
        for (int ab = 0; ab < 4; ++ab) { const int ai = ab >> 1, m0 = 2 * (ab & 1);
            u32x4 gq[2][2], pq[2][2]; float rq[2];
#pragma unroll
            for (int mm = 0; mm < 2; ++mm) { const int r = row0 + ai * HALF + (m0 + mm) * 16; rq[mm] = rs[r] * 1024.0f;
#pragma unroll
                for (int bj = 0; bj < 2; ++bj) { const int c = col0 + bj * HALF; gq[mm][bj] = *(const u32x4*)(gate + (size_t)r * ldg + c); if (MODE != 0) pq[mm][bj] = *(const u32x4*)(Mb + (size_t)r * ldc + c); } }
#pragma unroll
            for (int mm = 0; mm < 2; ++mm) { const int m = m0 + mm, r = row0 + ai * HALF + m * 16; const float rsc = rq[mm];
#pragma unroll
                for (int bj = 0; bj < 2; ++bj) { const int c = col0 + bj * HALF;
                    const u32x4 gw = gq[mm][bj];
                    f32x4 g0, g1;
                    g0[0] = __uint_as_float(gw.x << 16); g0[1] = __uint_as_float(gw.x & 0xffff0000u); g0[2] = __uint_as_float(gw.y << 16); g0[3] = __uint_as_float(gw.y & 0xffff0000u);
                    g1[0] = __uint_as_float(gw.z << 16); g1[1] = __uint_as_float(gw.z & 0xffff0000u); g1[2] = __uint_as_float(gw.w << 16); g1[3] = __uint_as_float(gw.w & 0xffff0000u);
#pragma unroll
                    for (int j = 0; j < 4; ++j) { g0[j] = act_apply(g0[j] * rsc * k0[bj][j], 3); g1[j] = act_apply(g1[j] * rsc * k1[bj][j], 3); }
                    f32x4 p0 = g0 * acc[ai][bj][m][0], p1 = g1 * acc[ai][bj][m][1];
                    bf16_t* mp = Mb + (size_t)r * ldc + c;
                    if (MODE != 0) { const u32x4 pw = pq[mm][bj];
                        p0[0] += __uint_as_float(pw.x << 16); p0[1] += __uint_as_float(pw.x & 0xffff0000u); p0[2] += __uint_as_float(pw.y << 16); p0[3] += __uint_as_float(pw.y & 0xffff0000u);
                        p1[0] += __uint_as_float(pw.z << 16); p1[1] += __uint_as_float(pw.z & 0xffff0000u); p1[2] += __uint_as_float(pw.w << 16); p1[3] += __uint_as_float(pw.w & 0xffff0000u); }
                    u32x4 w; w.x = cvt_pk_bf16(p0[0], p0[1]); w.y = cvt_pk_bf16(p0[2], p0[3]); w.z = cvt_pk_bf16(p1[0], p1[1]); w.w = cvt_pk_bf16(p1[2], p1[3]);
                    *(u32x4*)mp = w; } } }
    }
};
struct EpiSlab {
    static constexpr bool PERM = true, AFTER_DRAIN = false;
    float* slab;
    __device__ __forceinline__ void operator()(const f32x4 (&acc)[2][2][4][2], const Unit& u, int wr, int wc, int fr, int fq) const {
        const int row0 = wr * 64 + fr, col0 = wc * 32 + 8 * fq;
#pragma unroll
        for (int ai = 0; ai < 2; ++ai)
#pragma unroll
            for (int m = 0; m < 4; ++m)
#pragma unroll
                for (int bj = 0; bj < 2; ++bj) { float* p = slab + (row0 + ai * HALF + m * 16) * 256 + col0 + bj * HALF;
                    *(f32x4*)p = acc[ai][bj][m][0]; *(f32x4*)(p + 4) = acc[ai][bj][m][1]; }
    }
};
struct EpiGate {
    static constexpr bool PERM = true, AFTER_DRAIN = false;
    bf16_t* O; int ldc;
    __device__ __forceinline__ void operator()(const f32x4 (&acc)[2][2][4][2], const Unit& u, int wr, int wc, int fr, int fq) const {
        const int row0 = u.pm * BM + wr * 64 + fr, col0 = u.pn * BM + wc * 32 + 8 * fq;
#pragma unroll
        for (int ai = 0; ai < 2; ++ai)
#pragma unroll
            for (int m = 0; m < 4; ++m) { bf16_t* rowp = O + (size_t)(row0 + ai * HALF + m * 16) * ldc + col0;
#pragma unroll
                for (int bj = 0; bj < 2; ++bj) { const i32x4 a0 = __builtin_bit_cast(i32x4, acc[ai][bj][m][0]), a1 = __builtin_bit_cast(i32x4, acc[ai][bj][m][1]);
                    u32x4 w; w.x = cvt_pk_bf16((float)a0[0] * 0.0009765625f, (float)a0[1] * 0.0009765625f); w.y = cvt_pk_bf16((float)a0[2] * 0.0009765625f, (float)a0[3] * 0.0009765625f);
                    w.z = cvt_pk_bf16((float)a1[0] * 0.0009765625f, (float)a1[1] * 0.0009765625f); w.w = cvt_pk_bf16((float)a1[2] * 0.0009765625f, (float)a1[3] * 0.0009765625f);
                    *(u32x4*)(rowp + bj * HALF) = w; } }
    }
};
struct EpiRes {
    static constexpr bool PERM = false, AFTER_DRAIN = false;
    const float* base; float* out; int ldc;
    __device__ __forceinline__ void operator()(const f32x4 (&acc)[2][2][4][2], const Unit& u, int wr, int wc, int fr, int fq) const {
        const int row0 = u.pm * BM + wr * 64 + fr, col0 = u.pn * BM + wc * 32 + 4 * fq;
#pragma unroll
        for (int ai = 0; ai < 2; ++ai) {
            f32x4 bq[4][2][2];
#pragma unroll
            for (int m = 0; m < 4; ++m) { const size_t off = (size_t)(row0 + ai * HALF + m * 16) * ldc + col0;
#pragma unroll
                for (int bj = 0; bj < 2; ++bj)
#pragma unroll
                    for (int n = 0; n < 2; ++n) bq[m][bj][n] = *(const f32x4*)(base + off + bj * HALF + n * 16); }
#pragma unroll
            for (int m = 0; m < 4; ++m) { const size_t off = (size_t)(row0 + ai * HALF + m * 16) * ldc + col0;
#pragma unroll
                for (int bj = 0; bj < 2; ++bj)
#pragma unroll
                    for (int n = 0; n < 2; ++n) *(f32x4*)(out + off + bj * HALF + n * 16) = bq[m][bj][n] + acc[ai][bj][m][n]; } }
    }
};
template <class Epi, class Sched, bool ALIGN_EPI = false, bool SP2 = false, int DT = 0  >
__device__ __forceinline__ void gemm_phase(PG8_LAS unsigned char* lds, const Gemm g, const Sched& S, const Epi& E) {
    int tid_ = threadIdx.x; asm volatile("" : "+v"(tid_));
    const int tid = tid_, wid = __builtin_amdgcn_readfirstlane(tid >> 6), lane = tid & 63, wr = wid >> 2, wc = wid & 3, fr = lane & 15, fq = lane >> 4;
    const int K = g.K, nt = K / BK, LD = g.ld ? g.ld : g.K;
    unsigned voffA[2], voffB[2];
#pragma unroll
    for (int i = 0; i < 2; ++i) { int R, C; stage_rc(tid * 16 + i * 8192, R, C); const int Rb = Epi::PERM ? ((R & ~31) + perm32(R & 31)) : R;
        voffA[i] = (unsigned)(R * LD + C) * 2u; voffB[i] = (unsigned)(Rb * LD + C) * 2u; }
    const size_t kstep = (size_t)(BK * 2);
    const size_t hstep = (size_t)HALF * LD * 2;
    const size_t tstep = 2 * hstep;
    const unsigned ldsw = (unsigned)wid * 1024u;
    const int aoff = lds_byte(wr * 64 + fr, fq * 8), boff = lds_byte(wc * 32 + fr, fq * 8);
#define PG8_SA(b, h) (((b) * 2 + (h)) * HTB)
#define PG8_SB(b, h) ((4 + (b) * 2 + (h)) * HTB)
#define PG8_STAGE(bufoff, gbase, voff) do { _Pragma("unroll") for (int _i = 0; _i < 2; ++_i) \
        __builtin_amdgcn_global_load_lds((const unsigned*)((const char*)(gbase) + (voff)[_i]), (PG8_LAS unsigned*)(lds + (bufoff) + ldsw + _i * 8192), 16, 0, 0); } while (0)
#define PG8_LDA(dst, b, h) do { _Pragma("unroll") for (int m = 0; m < 4; ++m) _Pragma("unroll") for (int k = 0; k < 2; ++k) dst[m][k] = *(const PG8_LAS bf16x8*)(lds + PG8_SA(b, h) + aoff + m * 2048 + k * 1024); } while (0)
#define PG8_LDB(dst, b, h) do { _Pragma("unroll") for (int n = 0; n < 2; ++n) _Pragma("unroll") for (int k = 0; k < 2; ++k) dst[n][k] = *(const PG8_LAS bf16x8*)(lds + PG8_SB(b, h) + boff + n * 2048 + k * 1024); } while (0)
#define PG8_MMA(ai, bj, At, Bt) do { __builtin_amdgcn_s_setprio(1); \
        if constexpr (DT == 0) { _Pragma("unroll") for (int m = 0; m < 4; ++m) _Pragma("unroll") for (int n = 0; n < 2; ++n) _Pragma("unroll") for (int k = 0; k < 2; ++k) \
            acc[ai][bj][m][n] = mma16<DT>(Bt[n][k], At[m][k], acc[ai][bj][m][n]); } \
        else { _Pragma("unroll") for (int k = 0; k < 2; ++k) _Pragma("unroll") for (int m = 0; m < 4; ++m) _Pragma("unroll") for (int n = 0; n < 2; ++n)     \
            acc[ai][bj][m][n] = mma16<DT>(Bt[n][k], At[m][k], acc[ai][bj][m][n]); } \
        __builtin_amdgcn_s_setprio(0); } while (0)
#define PG8_WAIT_V(n) asm volatile("s_waitcnt vmcnt(" #n ")" ::: "memory")
#define PG8_WAIT_L(n) asm volatile("s_waitcnt lgkmcnt(" #n ")" ::: "memory")
#define PG8_BAR __builtin_amdgcn_s_barrier()
#define PG8_SCHED __builtin_amdgcn_sched_barrier(0)
    Unit cur, nxt; int ui = 0;
    if (!S.next(0, cur)) return;
    f32x4 acc[2][2][4][2];
#pragma unroll
    for (int a = 0; a < 2; ++a)
#pragma unroll
        for (int b = 0; b < 2; ++b)
#pragma unroll
            for (int m = 0; m < 4; ++m)
#pragma unroll
                for (int n = 0; n < 2; ++n) acc[a][b][m][n] = (f32x4){0.f, 0.f, 0.f, 0.f};
    bf16x8 At[4][2], B0[2][2], B1[2][2];
    const char* cA = (const char*)g.A + (size_t)cur.pm * tstep; const char* cB = (const char*)g.Bt + (size_t)cur.pn * tstep;
    S.a_ready(cur);
    if constexpr (SP2) {
        PG8_STAGE(PG8_SB(0, 0), cB, voffB); PG8_STAGE(PG8_SB(0, 1), cB + hstep, voffB); PG8_STAGE(PG8_SA(0, 0), cA, voffA); PG8_STAGE(PG8_SA(0, 1), cA + hstep, voffA);
        if (wr == 1) PG8_BAR;
        PG8_WAIT_V(2); PG8_BAR;
        PG8_STAGE(PG8_SB(1, 0), cB + kstep, voffB); PG8_STAGE(PG8_SA(1, 0), cA + kstep, voffA); PG8_STAGE(PG8_SB(1, 1), cB + hstep + kstep, voffB);
        PG8_WAIT_V(6); PG8_BAR;
    } else {
        PG8_STAGE(PG8_SB(0, 0), cB, voffB); PG8_STAGE(PG8_SA(0, 0), cA, voffA); PG8_STAGE(PG8_SB(0, 1), cB + hstep, voffB); PG8_STAGE(PG8_SA(0, 1), cA + hstep, voffA);
        if (wr == 1) PG8_BAR;
        PG8_WAIT_V(4); PG8_BAR;
        PG8_STAGE(PG8_SB(1, 0), cB + kstep, voffB); PG8_STAGE(PG8_SA(1, 0), cA + kstep, voffA); PG8_STAGE(PG8_SB(1, 1), cB + hstep + kstep, voffB);
        PG8_WAIT_V(6); PG8_BAR;
    }
    for (;;) {
        const bool has_next = S.next(ui + 1, nxt);
        const char* nA = has_next ? (const char*)g.A + (size_t)nxt.pm * tstep : cA; const char* nB = has_next ? (const char*)g.Bt + (size_t)nxt.pn * tstep : cB;
        for (int t = 0; t < nt; t += 2) {
            const bool last = (t == nt - 2);
            const char* a1 = cA + (size_t)(t + 1) * kstep;
            const char* a2 = last ? nA : cA + (size_t)(t + 2) * kstep; const char* b2 = last ? nB : cB + (size_t)(t + 2) * kstep;
            const char* a3 = a2 + kstep; const char* b3 = b2 + kstep;
            if (last && has_next) S.a_ready(nxt);
            if constexpr (SP2) {
            PG8_LDB(B0, 0, 0); PG8_LDB(B1, 0, 1); PG8_SCHED; PG8_LDA(At, 0, 0); PG8_STAGE(PG8_SA(1, 1), a1 + hstep, voffA);
            PG8_WAIT_V(8); PG8_WAIT_L(0); PG8_BAR; PG8_MMA(0, 0, At, B0); PG8_MMA(0, 1, At, B1); PG8_BAR; PG8_SCHED;
            PG8_LDA(At, 0, 1); PG8_STAGE(PG8_SB(0, 0), b2, voffB); PG8_STAGE(PG8_SB(0, 1), b2 + hstep, voffB); PG8_STAGE(PG8_SA(0, 0), a2, voffA);
            PG8_WAIT_V(8); PG8_WAIT_L(0); PG8_BAR; PG8_MMA(1, 0, At, B0); PG8_MMA(1, 1, At, B1); PG8_BAR; PG8_SCHED;
            PG8_LDB(B0, 1, 0); PG8_LDB(B1, 1, 1); PG8_SCHED; PG8_LDA(At, 1, 0); PG8_STAGE(PG8_SA(0, 1), a2 + hstep, voffA);
            PG8_WAIT_V(8); PG8_WAIT_L(0); PG8_BAR; PG8_MMA(0, 0, At, B0); PG8_MMA(0, 1, At, B1); PG8_BAR; PG8_SCHED;
            PG8_LDA(At, 1, 1); PG8_STAGE(PG8_SB(1, 0), b3, voffB); PG8_STAGE(PG8_SB(1, 1), b3 + hstep, voffB); PG8_STAGE(PG8_SA(1, 0), a3, voffA);
            PG8_WAIT_V(8); PG8_WAIT_L(0); PG8_BAR; PG8_MMA(1, 0, At, B0); PG8_MMA(1, 1, At, B1); PG8_BAR; PG8_SCHED;
            } else {
            PG8_LDB(B0, 0, 0); PG8_SCHED; PG8_LDA(At, 0, 0); PG8_STAGE(PG8_SA(1, 1), a1 + hstep, voffA);
            PG8_WAIT_L(8); PG8_BAR; PG8_WAIT_L(0); PG8_MMA(0, 0, At, B0); PG8_BAR; PG8_SCHED;
            PG8_LDB(B1, 0, 1); PG8_STAGE(PG8_SB(0, 0), b2, voffB);
            PG8_BAR; PG8_WAIT_L(0); PG8_MMA(0, 1, At, B1); PG8_BAR;
            PG8_LDA(At, 0, 1); PG8_STAGE(PG8_SA(0, 0), a2, voffA);
            PG8_BAR; PG8_WAIT_L(0); PG8_MMA(1, 0, At, B0); PG8_BAR; PG8_SCHED;
            PG8_STAGE(PG8_SB(0, 1), b2 + hstep, voffB);
            PG8_WAIT_V(6); PG8_BAR; PG8_MMA(1, 1, At, B1); PG8_BAR;
            PG8_LDB(B0, 1, 0); PG8_SCHED; PG8_LDA(At, 1, 0); PG8_STAGE(PG8_SA(0, 1), a2 + hstep, voffA);
            PG8_WAIT_L(8); PG8_BAR; PG8_WAIT_L(0); PG8_MMA(0, 0, At, B0); PG8_BAR; PG8_SCHED;
            PG8_LDB(B1, 1, 1); PG8_STAGE(PG8_SB(1, 0), b3, voffB);
            PG8_BAR; PG8_WAIT_L(0); PG8_MMA(0, 1, At, B1); PG8_BAR;
            PG8_LDA(At, 1, 1); PG8_STAGE(PG8_SA(1, 0), a3, voffA);
            PG8_BAR; PG8_WAIT_L(0); PG8_MMA(1, 0, At, B0); PG8_BAR; PG8_SCHED;
            PG8_STAGE(PG8_SB(1, 1), b3 + hstep, voffB);
            PG8_WAIT_V(6); PG8_BAR; PG8_MMA(1, 1, At, B1); PG8_BAR;
            }
        }
        if constexpr (ALIGN_EPI) { if (wr == 0) PG8_BAR; }
        if constexpr (!Epi::AFTER_DRAIN) { E(acc, cur, wr, wc, fr, fq); S.done(cur); }
        if (!has_next) break;
#pragma unroll
        for (int a = 0; a < 2; ++a)
#pragma unroll
            for (int b = 0; b < 2; ++b)
#pragma unroll
                for (int m = 0; m < 4; ++m)
#pragma unroll
                    for (int n = 0; n < 2; ++n) acc[a][b][m][n] = (f32x4){0.f, 0.f, 0.f, 0.f};
        cur = nxt; cA = nA; cB = nB; ++ui;
        if constexpr (ALIGN_EPI) { if (wr == 1) PG8_BAR; }
    }
    PG8_WAIT_V(0);
    if constexpr (!ALIGN_EPI) { if (wr == 0) PG8_BAR; }
    PG8_BAR;
    if constexpr (Epi::AFTER_DRAIN) { E.fused(acc, cur, wr, wc, fr, fq, lds, wid, lane); S.done(cur); }
#undef PG8_SA
#undef PG8_SB
#undef PG8_STAGE
#undef PG8_LDA
#undef PG8_LDB
#undef PG8_MMA
#undef PG8_WAIT_V
#undef PG8_WAIT_L
#undef PG8_BAR
#undef PG8_SCHED
}
}
constexpr int NWAVES = 8;
constexpr int BATCH = 2, SEQ = 8192, DM = 4096, MTOK = BATCH * SEQ, DEPTH = 2;
constexpr int NIN = 36000, NP = 36096;
constexpr int BW = 2048;
constexpr int C_RQ = 0, C_RK = 2048, C_RV = 4096, C_RG = 6144, C_DQ = 8192, C_DK = 10240, C_DV = 10752, C_IQ = 11264, C_IK = 15360, C_IW = 15488,
              C_DG = 15616, C_GU = 17664, C_GV = 19712, C_GG = 21760, C_MG = 23808;
constexpr int PAD_AT = 15520, PAD_N = 96;
constexpr float EPS = 1e-6f;
constexpr int NPHASE = 1 + 8 * DEPTH;
#ifndef G1_SPLIT
#define G1_SPLIT false
#endif
#ifndef GATE_I8
#define GATE_I8 1
#endif
#ifndef MK_PER_PHASE
#define MK_PER_PHASE 0
#endif

constexpr size_t MiB = 1ull << 20;
constexpr size_t WS_CTL = 0, CTL_ZERO_BYTES = 1 * MiB;
constexpr size_t WIN_BYTES = (size_t)NP * DM * 2;
constexpr size_t WS_WIN = 2 * MiB;
constexpr size_t WS_WBR = WS_WIN + DEPTH * WIN_BYTES;
constexpr size_t WBR_BYTES = (size_t)DM * BW * 2;
constexpr size_t WS_WOUT = WS_WBR + DEPTH * 3 * WBR_BYTES;
constexpr size_t WOUT_BYTES = (size_t)DM * DM * 2;
constexpr size_t WS_ROPE = WS_WOUT + DEPTH * WOUT_BYTES;
constexpr size_t WS_XN = WS_ROPE + 24 * MiB;
constexpr size_t WS_H = WS_XN + 128 * MiB;
constexpr size_t WS_X1 = WS_H + (size_t)MTOK * NP * 2;
constexpr size_t WS_SC = WS_X1 + 256 * MiB;
constexpr size_t WS_SEL = WS_SC + 512 * MiB;
constexpr size_t WS_KVP = WS_SEL + 16 * MiB;
constexpr size_t WS_RST = WS_KVP + 256 * MiB;
constexpr size_t WS_SS = WS_RST + 256 * MiB;
constexpr size_t WS_OUTF = WS_SS + 64 * MiB;
constexpr size_t WS_Y = WS_OUTF + 128 * MiB;
constexpr size_t WS_M32 = WS_Y + 192 * MiB;
constexpr size_t WS_MB = WS_M32 + 256 * MiB;
constexpr size_t WS_GVS = WS_MB + 128 * MiB;
constexpr size_t WS_IQP = WS_GVS + 1 * MiB;
constexpr size_t WS_WSB = WS_IQP + 128 * MiB;
constexpr size_t WS_XQ = WS_WSB + 1 * MiB;
constexpr size_t WS_WQ = WS_WIN;
constexpr size_t WQ_BYTES = (size_t)NP * DM;
constexpr size_t WS_RSC = WS_XQ + 64 * MiB;
constexpr size_t WS_K8 = WS_RSC + 1 * MiB;
constexpr size_t WS_V8 = WS_K8 + 8 * MiB;
constexpr size_t WS_END = WS_V8 + 8 * MiB;
constexpr int CW_BAR = 4096;
constexpr int CW_PQ = 2048;
constexpr int CW_TK = 1024;
constexpr int CW_QIDX = 64;
constexpr int LDS_BYTES = 147456;
constexpr int MISC_OFF = LDS_BYTES - 256;

#define GAS __attribute__((address_space(1)))
#define LAS __attribute__((address_space(3)))
typedef unsigned short bf16;
typedef unsigned v4u __attribute__((ext_vector_type(4)));
typedef float f32x4 __attribute__((ext_vector_type(4)));
typedef float f32x16 __attribute__((ext_vector_type(16)));
typedef short bf16x8 __attribute__((ext_vector_type(8)));
constexpr int NG = 3 * DM;
constexpr int NIN_BF = NIN - NG;
#define LDS_WAIT() asm volatile("s_waitcnt lgkmcnt(0)" ::: "memory")
#define VM_WAIT() asm volatile("s_waitcnt vmcnt(0)" ::: "memory")
__device__ __forceinline__ float bf2f(unsigned short b) { return __uint_as_float(((unsigned)b) << 16); }
__device__ __forceinline__ unsigned f2bf(float f) { unsigned u = __float_as_uint(f); return (u + 0x7fffu + ((u >> 16) & 1u)) >> 16; }
__device__ __forceinline__ unsigned pk2(float lo, float hi) { return f2bf(lo) | (f2bf(hi) << 16); }
__device__ __forceinline__ float lo16(unsigned w) { return __uint_as_float(w << 16); }
__device__ __forceinline__ float hi16(unsigned w) { return __uint_as_float(w & 0xffff0000u); }
__device__ __forceinline__ int lane_now() { int l = (int)__builtin_amdgcn_mbcnt_hi(~0u, __builtin_amdgcn_mbcnt_lo(~0u, 0u)); asm volatile("" : "+v"(l)); return l; }
template <int O> __device__ __forceinline__ float shx(float v) {
    if constexpr (O < 32) return __int_as_float(__builtin_amdgcn_ds_swizzle(__float_as_int(v), (O << 10) | 0x1f));
    else return __int_as_float(__builtin_amdgcn_ds_bpermute((lane_now() ^ O) << 2, __float_as_int(v)));
}
__device__ __forceinline__ unsigned sh_up(unsigned v, int o) { return (unsigned)__builtin_amdgcn_ds_bpermute((lane_now() - o) << 2, (int)v); }
__device__ __forceinline__ unsigned sh_idx(unsigned v, int src) { return (unsigned)__builtin_amdgcn_ds_bpermute(src << 2, (int)v); }
__device__ __forceinline__ float wave_sum(float v) { v += shx<1>(v); v += shx<2>(v); v += shx<4>(v); v += shx<8>(v); v += shx<16>(v); v += shx<32>(v); return v; }
__device__ __forceinline__ float wave_max(float v) { v = fmaxf(v, shx<1>(v)); v = fmaxf(v, shx<2>(v)); v = fmaxf(v, shx<4>(v)); v = fmaxf(v, shx<8>(v)); v = fmaxf(v, shx<16>(v)); v = fmaxf(v, shx<32>(v)); return v; }

#define XB_TMO      128
#define XB_XCNT(j)  (256  + 64 * (j))
#define XB_XSUB(j)  (1280 + 64 * (j))
#define XB_XGEN(j)  (2304 + 64 * (j))
#define XB_TOP      3328
#define XB_TOPGEN   3392
#define XCD_BAR_WORDS 3456
#define XB_SPIN_CAP (1u << 22)

__device__ __forceinline__ unsigned xb_ld(unsigned* p)              { return __hip_atomic_load(p, __ATOMIC_RELAXED, __HIP_MEMORY_SCOPE_AGENT); }
__device__ __forceinline__ unsigned xb_add(unsigned* p, unsigned v) { return __hip_atomic_fetch_add(p, v, __ATOMIC_RELAXED, __HIP_MEMORY_SCOPE_AGENT); }
__device__ __forceinline__ unsigned xb_xcc_id() { return (unsigned)__builtin_amdgcn_s_getreg((3 << 11) | 20) & 0xFu; }
#define XB_SPIN(cond, bar) do { unsigned _sp = 0; while (cond) { __builtin_amdgcn_s_sleep(1); \
    if ((++_sp & 255u) == 0u) { if (xb_ld(&(bar)[XB_TMO])) break; if (_sp > XB_SPIN_CAP) { atomicAdd(&(bar)[XB_TMO], 1u); break; } } } } while (0)

struct XcdBarrier {
    unsigned* bar; unsigned x;
    volatile LAS unsigned* st;
};

__device__ __forceinline__ XcdBarrier xcd_barrier_post(unsigned* bar, volatile LAS unsigned* st) {
    XcdBarrier b; b.bar = bar; b.x = xb_xcc_id(); b.st = st;
    if (threadIdx.x == 0) (void)xb_add(&bar[XB_XCNT(b.x)], 1u);
    return b;
}
__device__ __forceinline__ void xcd_barrier_complete(unsigned* bar, unsigned x, unsigned& nloc, unsigned& nx) {
    const unsigned G = gridDim.x * gridDim.y * gridDim.z;
    unsigned sum, cnt, mine, sp = 0u;
    for (;;) {
        sum = 0u; cnt = 0u; mine = 0u;
#pragma unroll
        for (unsigned j = 0; j < 16; ++j) { const unsigned c = xb_ld(&bar[XB_XCNT(j)]); sum += c; cnt += (c > 0u) ? 1u : 0u; mine = (j == x) ? c : mine; }
        if (sum == G) break;
        __builtin_amdgcn_s_sleep(1);
        if ((++sp & 255u) == 0u) { if (xb_ld(&bar[XB_TMO])) break; if (sp > XB_SPIN_CAP) { atomicAdd(&bar[XB_TMO], 1u); break; } }
    }
    nloc = mine > 0u ? mine : 1u; nx = cnt > 0u ? cnt : 1u;
}

__device__ __forceinline__ void xcd_barrier(const XcdBarrier& b) {
    asm volatile("s_waitcnt vmcnt(0)" ::: "memory");
    __syncthreads();
    if (threadIdx.x == 0) {
        unsigned* bar = b.bar;
        __builtin_amdgcn_s_waitcnt(0);
        unsigned nloc = b.st[0], nx = b.st[1];
        if (nloc == 0u) { xcd_barrier_complete(bar, b.x, nloc, nx); b.st[0] = nloc; b.st[1] = nx; }
        const unsigned old = xb_add(&bar[XB_XSUB(b.x)], 1u);
        const unsigned gen = old / nloc;
        if (old + 1u == (gen + 1u) * nloc) {
            __builtin_amdgcn_fence(__ATOMIC_RELEASE, "agent");
            asm volatile("s_waitcnt vmcnt(0)" ::: "memory");
            const unsigned og = xb_add(&bar[XB_TOP], 1u);
            const unsigned tg = og / nx;
            if (og + 1u == (tg + 1u) * nx) xb_add(&bar[XB_TOPGEN], 1u);
            else XB_SPIN(xb_ld(&bar[XB_TOPGEN]) == tg, bar);
            __builtin_amdgcn_fence(__ATOMIC_ACQUIRE, "agent");
            xb_add(&bar[XB_XGEN(b.x)], 1u);
            asm volatile("s_waitcnt vmcnt(0)" ::: "memory");
        } else {
            XB_SPIN(xb_ld(&bar[XB_XGEN(b.x)]) == gen, bar);
            __builtin_amdgcn_fence(__ATOMIC_ACQUIRE, "agent");
            asm volatile("s_waitcnt vmcnt(0)" ::: "memory");
        }
    }
    __syncthreads();
}

struct Args { const float* in[12]; float* out; unsigned char* ws; int ph_lo, ph_hi; };
struct Ctx { LAS unsigned char* lds; int tid, lane, wave, G, bx; };
enum { IN_X = 0, IN_POS, IN_NG, IN_WIN, IN_RNG, IN_QNG, IN_KNG, IN_GMG, IN_WS, IN_BS, IN_WBR, IN_WOUT };

__device__ __forceinline__ void transpose_item(const float* W, int K, int N, int nblk, bf16* WT, int item, int pad_at, int pad_n, LAS float* scr, int lane) {
    const int kb = item / nblk, nb = item % nblk, k0 = 64 * kb, n0 = 32 * nb;
    const int row_off = (n0 >= pad_at) ? pad_n : 0;
    { const int r8 = lane >> 3, c4 = lane & 7; f32x4 v[8];
#pragma unroll
      for (int i = 0; i < 8; ++i) v[i] = *(const f32x4*)(W + (size_t)(k0 + 8 * i + r8) * N + n0 + 4 * c4);
#pragma unroll
      for (int i = 0; i < 8; ++i)
#pragma unroll
          for (int j = 0; j < 4; ++j) scr[(8 * i + r8) * 33 + 4 * c4 + j] = v[i][j]; }
    LDS_WAIT(); asm volatile("" ::: "memory");
    const int c = lane & 7;
#pragma unroll
    for (int j = 0; j < 4; ++j) { const int n = (lane >> 3) + 8 * j; const LAS float* s = scr + (8 * c) * 33 + n;
        v4u o; o.x = pk2(s[0 * 33], s[1 * 33]); o.y = pk2(s[2 * 33], s[3 * 33]); o.z = pk2(s[4 * 33], s[5 * 33]); o.w = pk2(s[6 * 33], s[7 * 33]);
        *(v4u*)(WT + (size_t)(row_off + n0 + n) * K + k0 + 8 * c) = o; }
    LDS_WAIT(); asm volatile("" ::: "memory");
}
__device__ __forceinline__ void ph_prologue(const Args& a, const Ctx& c) {
    LAS float* scr = (LAS float*)(c.lds + c.wave * 16384);
    const int gw = c.bx * NWAVES + c.wave, NGW = c.G * NWAVES;
    constexpr int I_IN = 0, I_BR = (BW / 64) * (DM / 32), I_OUT = (DM / 64) * (DM / 32);
    constexpr int NITEMS = DEPTH * I_IN + DEPTH * 3 * I_BR + DEPTH * I_OUT;
    for (int it = gw; it < NITEMS; it += NGW) {
        int r = it;
        r -= DEPTH * I_IN;
        if (r < DEPTH * 3 * I_BR) { const int li = r / I_BR; r -= li * I_BR;
            transpose_item(a.in[IN_WBR] + (size_t)li * BW * DM, BW, DM, DM / 32, (bf16*)(a.ws + WS_WBR + li * WBR_BYTES), r, 0x7fffffff, 0, scr, c.lane); continue; }
        r -= DEPTH * 3 * I_BR;
        { const int l = r / I_OUT; r -= l * I_OUT;
            transpose_item(a.in[IN_WOUT] + (size_t)l * DM * DM, DM, DM, DM / 32, (bf16*)(a.ws + WS_WOUT + l * WOUT_BYTES), r, 0x7fffffff, 0, scr, c.lane); }
    }
    { LAS float* cmax = (LAS float*)(c.lds + 131072);
      const int r8 = c.lane >> 3, c4 = c.lane & 7;
      for (int s = c.bx; s < DEPTH * (NIN / 32); s += c.G) { const int l = s / (NIN / 32), nb = s % (NIN / 32), nrow = 32 * nb + (32 * nb >= PAD_AT ? PAD_N : 0);
        const float* W = a.in[IN_WIN] + (size_t)l * DM * NIN + 32 * nb + 4 * c4;
        f32x4 mx = {0.f, 0.f, 0.f, 0.f};
        for (int it = 0; it < 8; ++it) { const int k0 = 512 * c.wave + 64 * it;
            f32x4 v[8];
#pragma unroll
            for (int i = 0; i < 8; ++i) v[i] = *(const f32x4*)(W + (size_t)(k0 + 8 * i + r8) * NIN);
#pragma unroll
            for (int i = 0; i < 8; ++i)
#pragma unroll
                for (int j = 0; j < 4; ++j) mx[j] = fmaxf(mx[j], fabsf(v[i][j])); }
#pragma unroll
        for (int j = 0; j < 4; ++j) { mx[j] = fmaxf(mx[j], shx<8>(mx[j])); mx[j] = fmaxf(mx[j], shx<16>(mx[j])); mx[j] = fmaxf(mx[j], shx<32>(mx[j])); }
        if (c.lane < 8) *(LAS f32x4*)(cmax + c.wave * 32 + 4 * c.lane) = mx;
        __syncthreads();
        f32x4 cm = {0.f, 0.f, 0.f, 0.f};
#pragma unroll
        for (int w8 = 0; w8 < 8; ++w8) { const f32x4 t = *(const LAS f32x4*)(cmax + w8 * 32 + 4 * c4);
#pragma unroll
            for (int j = 0; j < 4; ++j) cm[j] = fmaxf(cm[j], t[j]); }
        f32x4 inv;
#pragma unroll
        for (int j = 0; j < 4; ++j) inv[j] = cm[j] > 0.f ? 127.0f / cm[j] : 0.f;
        if (c.wave == 0 && c.lane < 8) *(f32x4*)((float*)(a.ws + WS_RSC) + DEPTH * MTOK + l * NP + nrow + 4 * c.lane) = cm * (1.0f / 127.0f);
        unsigned char* WQ = (unsigned char*)(a.ws + WS_WQ + l * WQ_BYTES);
        for (int it = 0; it < 8; ++it) { const int k0 = 512 * c.wave + 64 * it;
            f32x4 v[8];
#pragma unroll
            for (int i = 0; i < 8; ++i) v[i] = *(const f32x4*)(W + (size_t)(k0 + 8 * i + r8) * NIN);
#pragma unroll
            for (int i = 0; i < 8; ++i)
#pragma unroll
                for (int j = 0; j < 4; ++j) scr[(8 * i + r8) * 33 + 4 * c4 + j] = __builtin_rintf(v[i][j] * inv[j]);
            LDS_WAIT(); asm volatile("" ::: "memory");
            const int cc8 = c.lane & 7;
#pragma unroll
            for (int j = 0; j < 4; ++j) { const int n = (c.lane >> 3) + 8 * j; const LAS float* sp = scr + (8 * cc8) * 33 + n;
                const unsigned lo = ((unsigned)(int)sp[0 * 33] & 255u) | (((unsigned)(int)sp[1 * 33] & 255u) << 8) | (((unsigned)(int)sp[2 * 33] & 255u) << 16) | (((unsigned)(int)sp[3 * 33] & 255u) << 24);
                const unsigned hi = ((unsigned)(int)sp[4 * 33] & 255u) | (((unsigned)(int)sp[5 * 33] & 255u) << 8) | (((unsigned)(int)sp[6 * 33] & 255u) << 16) | (((unsigned)(int)sp[7 * 33] & 255u) << 24);
                *(unsigned long long*)(WQ + (size_t)(nrow + n) * DM + k0 + 8 * cc8) = (unsigned long long)lo | ((unsigned long long)hi << 32); }
            LDS_WAIT(); asm volatile("" ::: "memory"); }
        __syncthreads();
      } }
    const int gt = c.bx * (NWAVES * 64) + c.tid, NGT = c.G * NWAVES * 64;
    for (int i = gt; i < DEPTH * PAD_N * DM / 16; i += NGT) { const int l = i / (PAD_N * DM / 16), r = i % (PAD_N * DM / 16);
        *(v4u*)((unsigned char*)(a.ws + WS_WQ + l * WQ_BYTES) + (size_t)PAD_AT * DM + (size_t)r * 16) = (v4u){0u, 0u, 0u, 0u}; }
    if (gt < DEPTH * PAD_N) ((float*)(a.ws + WS_RSC))[DEPTH * MTOK + (gt / PAD_N) * NP + PAD_AT + gt % PAD_N] = 0.f;
    { const float* wsp = a.in[IN_WS]; bf16* WSB = (bf16*)(a.ws + WS_WSB);
      for (int i = gt; i < DEPTH * 16 * 128 * 128; i += NGT) { const int s = i & 127, t = (i >> 7) & 127; WSB[i] = (bf16)f2bf(s <= t ? wsp[i] : 0.f); } }
    const int* pos = (const int*)a.in[IN_POS];
    float* cosT = (float*)(a.ws + WS_ROPE); float* sinT = cosT + (size_t)MTOK * 128;
    for (int idx = gt; idx < MTOK * 128; idx += NGT) { const int m = idx >> 7, i = idx & 127;
        double p = 1.0, bb = 1.0746078283213174; int e = i; while (e) { if (e & 1) p *= bb; bb *= bb; e >>= 1; }
        const float pf = (float)p; const float inv = 1.0f / pf; const float ang = (float)pos[m] * inv;
        const double ad = (double)ang; const double kq = __builtin_rint(ad * 0.6366197723675814);
        double r = __builtin_fma(-kq, 1.5707963267948966, ad); r = __builtin_fma(-kq, 6.123233995736766e-17, r);
        const double r2 = r * r;
        const double sn = r * (1.0 + r2 * (-1.0 / 6 + r2 * (1.0 / 120 + r2 * (-1.0 / 5040 + r2 * (1.0 / 362880 + r2 * (-1.0 / 39916800 + r2 * (1.0 / 6227020800.0)))))));
        const double cs = 1.0 + r2 * (-0.5 + r2 * (1.0 / 24 + r2 * (-1.0 / 720 + r2 * (1.0 / 40320 + r2 * (-1.0 / 3628800 + r2 * (1.0 / 479001600.0 + r2 * (-1.0 / 87178291200.0)))))));
        const int q = (int)((long long)kq & 3);
        const double sv = q == 0 ? sn : q == 1 ? cs : q == 2 ? -sn : -cs, cv = q == 0 ? cs : q == 1 ? -sn : q == 2 ? -cs : sn;
        cosT[idx] = (float)cv; sinT[idx] = (float)sv;
        if ((i & 1) == 0) { cosT[(size_t)MTOK * 256 + (size_t)m * 64 + (i >> 1)] = (float)cv; cosT[(size_t)MTOK * 320 + (size_t)m * 64 + (i >> 1)] = (float)sv; } }
}

__device__ __forceinline__ void ph_norm(const Args& a, const Ctx& c, int l) {
    const float* src = (l == 0) ? a.in[IN_X] : (const float*)(a.ws + WS_X1);
    const float* gain = a.in[IN_NG] + (size_t)l * DM;
    unsigned char* XQ = (unsigned char*)(a.ws + WS_XQ);
    const int gw = c.bx * NWAVES + c.wave, NGW = c.G * NWAVES;
    for (int m = gw; m < MTOK; m += NGW) {
        const f32x4* xr = (const f32x4*)(src + (size_t)m * DM) + c.lane;
        f32x4 v[16]; float ss = 0.f;
#pragma unroll
        for (int j = 0; j < 16; ++j) { v[j] = xr[64 * j]; ss += (v[j][0] * v[j][0] + v[j][1] * v[j][1]) + (v[j][2] * v[j][2] + v[j][3] * v[j][3]); }
        const float r = 1.0f / sqrtf(wave_sum(ss) * (1.0f / DM) + EPS);
        float amax = 0.f;
#pragma unroll
        for (int j = 0; j < 16; ++j) { const f32x4 g4 = ((const f32x4*)gain)[c.lane + 64 * j];
            v[j][0] *= r * g4[0]; v[j][1] *= r * g4[1]; v[j][2] *= r * g4[2]; v[j][3] *= r * g4[3];
            amax = fmaxf(fmaxf(amax, fmaxf(fabsf(v[j][0]), fabsf(v[j][1]))), fmaxf(fabsf(v[j][2]), fabsf(v[j][3]))); }
        amax = wave_max(amax);
        const float qi = amax > 0.f ? 127.0f / amax : 0.f;
        unsigned* q4 = (unsigned*)(XQ + (size_t)m * DM) + c.lane;
#pragma unroll
        for (int j = 0; j < 16; ++j) q4[64 * j] = ((unsigned)(int)__builtin_rintf(v[j][0] * qi) & 255u) | (((unsigned)(int)__builtin_rintf(v[j][1] * qi) & 255u) << 8)
            | (((unsigned)(int)__builtin_rintf(v[j][2] * qi) & 255u) << 16) | (((unsigned)(int)__builtin_rintf(v[j][3] * qi) & 255u) << 24);
        if (c.lane == 0) ((float*)(a.ws + WS_RSC))[(size_t)l * MTOK + m] = amax * (1.0f / 127.0f);
    }
}

__device__ __forceinline__ void unpack8(const v4u w, float (&x)[8]) { x[0] = lo16(w.x); x[1] = hi16(w.x); x[2] = lo16(w.y); x[3] = hi16(w.y); x[4] = lo16(w.z); x[5] = hi16(w.z); x[6] = lo16(w.w); x[7] = hi16(w.w); }
__device__ __forceinline__ v4u pack8(const float (&x)[8]) { v4u o; o.x = pk2(x[0], x[1]); o.y = pk2(x[2], x[3]); o.z = pk2(x[4], x[5]); o.w = pk2(x[6], x[7]); return o; }
__device__ __forceinline__ unsigned long long pack8_fp8(const float (&x)[8]) {
    int w0 = __builtin_amdgcn_cvt_pk_fp8_f32(x[0], x[1], 0, false); w0 = __builtin_amdgcn_cvt_pk_fp8_f32(x[2], x[3], w0, true);
    int w1 = __builtin_amdgcn_cvt_pk_fp8_f32(x[4], x[5], 0, false); w1 = __builtin_amdgcn_cvt_pk_fp8_f32(x[6], x[7], w1, true);
    return (unsigned long long)(unsigned)w0 | ((unsigned long long)(unsigned)w1 << 32); }
typedef unsigned u32x2_t __attribute__((ext_vector_type(2)));
__device__ __forceinline__ v4u swap16_pair(unsigned aLo, unsigned aHi, unsigned bLo, unsigned bHi) {
    const u32x2_t l = __builtin_amdgcn_permlane16_swap(aLo, bLo, false, false), h = __builtin_amdgcn_permlane16_swap(aHi, bHi, false, false);
    return (v4u){l.x, h.x, l.y, h.y};
}
__device__ __forceinline__ void loadh(const bf16* hp, const LAS float* csl, float rsc, int col, float (&x)[8]) {
    unpack8(*(const v4u*)(hp + col), x); const f32x4 k0 = *(const LAS f32x4*)(csl + col), k1 = *(const LAS f32x4*)(csl + col + 4);
#pragma unroll
    for (int e = 0; e < 4; ++e) { x[e] *= rsc * k0[e]; x[4 + e] *= rsc * k1[e]; }
}
__device__ __forceinline__ void scaleh(const v4u raw, const LAS float* csl, float rsc, int col, float (&x)[8]) {
    unpack8(raw, x); const f32x4 k0 = *(const LAS f32x4*)(csl + col), k1 = *(const LAS f32x4*)(csl + col + 4);
#pragma unroll
    for (int e = 0; e < 4; ++e) { x[e] *= rsc * k0[e]; x[4 + e] *= rsc * k1[e]; }
}
template <int ACT> __device__ __forceinline__ void prep_seg(bf16* hp, const LAS float* csl, float rsc, int c0, int c1, int lane) {
    for (int col = c0 + lane * 8; col < c1; col += 512) { float x[8]; loadh(hp, csl, rsc, col, x);
        if (ACT != 0) {
#pragma unroll
            for (int e = 0; e < 8; ++e) x[e] = pg8::act_apply(x[e], ACT); }
        *(v4u*)(hp + col) = pack8(x); }
}
__device__ __forceinline__ void ph_prep(const Args& a, const Ctx& c, int l) {
    bf16* H = (bf16*)(a.ws + WS_H);
    const float* cosT = (const float*)(a.ws + WS_ROPE); const float* sinT = cosT + (size_t)MTOK * 128;
    const float* cos1 = cosT + (size_t)MTOK * 256; const float* sin1 = cosT + (size_t)MTOK * 320;
    const float* qg = a.in[IN_QNG] + l * 128; const float* kg = a.in[IN_KNG] + l * 128;
    float* GVS = (float*)(a.ws + WS_GVS); bf16* IQP = (bf16*)(a.ws + WS_IQP); unsigned char* K8 = (unsigned char*)(a.ws + WS_K8);
    const float* rsl = (const float*)(a.ws + WS_RSC) + (size_t)l * MTOK; const float* csg = (const float*)(a.ws + WS_RSC) + DEPTH * MTOK + l * NP;
    const LAS float* csl = (const LAS float*)c.lds;
    for (int i = c.tid; i < C_GG / 4; i += NWAVES * 64) *(LAS f32x4*)(c.lds + 16 * i) = *(const f32x4*)(csg + 4 * i);
    __syncthreads();
    const int gw = c.bx * NWAVES + c.wave, NGW = c.G * NWAVES, lane = c.lane;
    const int i2 = 8 * (lane & 15), h2 = lane >> 4;
    const int i1 = 8 * (lane & 7), h1 = lane >> 3;
    float gq0[8], gq1[8], gk0[8], gk1[8];
#pragma unroll
    for (int e = 0; e < 8; ++e) { gq0[e] = qg[i1 + e]; gq1[e] = qg[i1 + 64 + e]; gk0[e] = kg[i1 + e]; gk1[e] = kg[i1 + 64 + e]; }
    const bool dyn = (c.G & 7) == 0; unsigned* ctr = (unsigned*)(a.ws + WS_CTL) + CW_PQ + (l * 8 + (c.bx & 7)) * 16;
    unsigned pq = 0u;
    if (dyn) { if (lane == 0) pq = __hip_atomic_fetch_add(ctr, 1u, __ATOMIC_RELAXED, __HIP_MEMORY_SCOPE_AGENT); pq = (unsigned)__builtin_amdgcn_readfirstlane((int)pq); }
    for (int m = dyn ? (int)pq * 8 + (c.bx & 7) : gw; dyn ? pq < 2048u : m < MTOK; ) {
        unsigned pqn = 0u;
        if (dyn && lane == 0) pqn = __hip_atomic_fetch_add(ctr, 1u, __ATOMIC_RELAXED, __HIP_MEMORY_SCOPE_AGENT);
        bf16* hp = H + (size_t)m * NP;
        const float rsc = rsl[m] * 1024.0f;
        float c2[8], s2[8], c1[8], s1[8];
        { const f32x4 a0 = *(const f32x4*)(cosT + (size_t)m * 128 + i2), a1 = *(const f32x4*)(cosT + (size_t)m * 128 + i2 + 4), b0 = *(const f32x4*)(sinT + (size_t)m * 128 + i2), b1 = *(const f32x4*)(sinT + (size_t)m * 128 + i2 + 4);
          const f32x4 d0 = *(const f32x4*)(cos1 + (size_t)m * 64 + i1), d1 = *(const f32x4*)(cos1 + (size_t)m * 64 + i1 + 4), e0 = *(const f32x4*)(sin1 + (size_t)m * 64 + i1), e1 = *(const f32x4*)(sin1 + (size_t)m * 64 + i1 + 4);
#pragma unroll
          for (int e = 0; e < 4; ++e) { c2[e] = a0[e]; c2[4 + e] = a1[e]; s2[e] = b0[e]; s2[4 + e] = b1[e]; c1[e] = d0[e]; c1[4 + e] = d1[e]; s1[e] = e0[e]; s1[4 + e] = e1[e]; } }
        v4u ra[4][2], rb[3][2], rdv;
#pragma unroll
        for (int it = 0; it < 4; ++it) { const int col = C_RQ + (4 * it + h2) * 256 + i2; ra[it][0] = *(const v4u*)(hp + col); ra[it][1] = *(const v4u*)(hp + col + 128); }
#pragma unroll
        for (int it = 0; it < 3; ++it) { const int hd = 8 * it + h1 < 20 ? 8 * it + h1 : 19, col = C_DQ + hd * 128 + i1; rb[it][0] = *(const v4u*)(hp + col); rb[it][1] = *(const v4u*)(hp + col + 64); }
        rdv = *(const v4u*)(hp + C_DV + lane * 8);
#pragma unroll
        for (int it = 0; it < 4; ++it) {
            const int col = C_RQ + (4 * it + h2) * 256 + i2; const float sc = it < 2 ? 1.0f : 0.0625f;
            float x1[8], x2[8], y1[8], y2[8]; scaleh(ra[it][0], csl, rsc, col, x1); scaleh(ra[it][1], csl, rsc, col + 128, x2);
#pragma unroll
            for (int e = 0; e < 8; ++e) { y1[e] = (x1[e] * c2[e] - x2[e] * s2[e]) * sc; y2[e] = (x2[e] * c2[e] + x1[e] * s2[e]) * sc; }
            *(v4u*)(hp + col) = pack8(y1); *(v4u*)(hp + col + 128) = pack8(y2);
        }
#pragma unroll
        for (int it = 0; it < 3; ++it) {
            const int hd = 8 * it + h1;
            if (hd < 20) { const int col = C_DQ + hd * 128 + i1;
                float x1[8], x2[8], y1[8], y2[8]; scaleh(rb[it][0], csl, rsc, col, x1); scaleh(rb[it][1], csl, rsc, col + 64, x2);
                float ss = 0.f;
#pragma unroll
                for (int e = 0; e < 8; ++e) ss += x1[e] * x1[e] + x2[e] * x2[e];
                ss += shx<1>(ss); ss += shx<2>(ss); ss += shx<4>(ss);
                const float r = 1.0f / sqrtf(ss * (1.0f / 128.0f) + EPS);
#pragma unroll
                for (int e = 0; e < 8; ++e) { const float u1 = x1[e] * r * (hd < 16 ? gq0[e] : gk0[e]), u2 = x2[e] * r * (hd < 16 ? gq1[e] : gk1[e]);
                    y1[e] = u1 * c1[e] - u2 * s1[e]; y2[e] = u2 * c1[e] + u1 * s1[e]; }
                *(v4u*)(hp + col) = pack8(y1); *(v4u*)(hp + col + 64) = pack8(y2);
                if (hd >= 16) { unsigned char* k8 = K8 + (size_t)m * 512 + (hd - 16) * 128 + i1;
                    *(unsigned long long*)k8 = pack8_fp8(y1); *(unsigned long long*)(k8 + 64) = pack8_fp8(y2); } }
        }
        { float x[8]; scaleh(rdv, csl, rsc, C_DV + lane * 8, x); *(unsigned long long*)((unsigned char*)(a.ws + WS_V8) + (size_t)m * 512 + lane * 8) = pack8_fp8(x); }
        bf16* iqp = IQP + (size_t)m * 4096;
        v4u rc[5][2], rgv[4], riw;
#pragma unroll
        for (int it = 0; it < 5; ++it) { const int hd = 8 * it + h1 < 33 ? 8 * it + h1 : 32, col = C_IQ + hd * 128 + i1; rc[it][0] = *(const v4u*)(hp + col); rc[it][1] = *(const v4u*)(hp + col + 64); }
#pragma unroll
        for (int j = 0; j < 4; ++j) rgv[j] = *(const v4u*)(hp + C_GV + (lane + 64 * j) * 8);
        riw = *(const v4u*)(hp + C_IW + (lane & 3) * 8);
#pragma unroll
        for (int it = 0; it < 5; ++it) {
            const int hd = 8 * it + h1;
            if (hd < 33) { const int col = C_IQ + hd * 128 + i1;
                float x1[8], x2[8], y1[8], y2[8]; scaleh(rc[it][0], csl, rsc, col, x1); scaleh(rc[it][1], csl, rsc, col + 64, x2);
#pragma unroll
                for (int e = 0; e < 8; ++e) { y1[e] = x1[e] * c1[e] - x2[e] * s1[e]; y2[e] = x2[e] * c1[e] + x1[e] * s1[e]; }
                if (hd < 32) { *(v4u*)(iqp + ((lane & 7) * 32 + hd) * 8) = pack8(y1); *(v4u*)(iqp + ((8 + (lane & 7)) * 32 + hd) * 8) = pack8(y2); }
                else { *(v4u*)(hp + col) = pack8(y1); *(v4u*)(hp + col + 64) = pack8(y2); } }
        }
        if (lane < 4) { float x[8]; scaleh(riw, csl, rsc, C_IW + lane * 8, x); *(v4u*)(hp + C_IW + lane * 8) = pack8(x); }
        {
            float v[32]; float s = 0.f;
#pragma unroll
            for (int j = 0; j < 4; ++j) { float x[8]; scaleh(rgv[j], csl, rsc, C_GV + (lane + 64 * j) * 8, x);
#pragma unroll
                for (int e = 0; e < 8; ++e) { x[e] = pg8::act_apply(x[e], 2); }
                const v4u w = pack8(x); *(v4u*)(hp + C_GV + (lane + 64 * j) * 8) = w;
                unpack8(w, x);
#pragma unroll
                for (int e = 0; e < 8; ++e) { v[8 * j + e] = x[e]; s += x[e]; } }
            const float mean = wave_sum(s) * (1.0f / 2048.0f); float q = 0.f;
#pragma unroll
            for (int j = 0; j < 32; ++j) { const float d = v[j] - mean; q += d * d; }
            const float rstd = 1.0f / sqrtf(wave_sum(q) * (1.0f / 2048.0f) + EPS);
            if (lane == 0) { GVS[2 * m] = mean; GVS[2 * m + 1] = rstd; }
        }
        if (dyn) { pq = (unsigned)__builtin_amdgcn_readfirstlane((int)pqn); m = (int)pq * 8 + (c.bx & 7); } else m += NGW;
    }
}

typedef short s16x4 __attribute__((ext_vector_type(4)));
__device__ __forceinline__ float ret_logg(int h) { return logf(1.0f - exp2f(-5.0f - (float)h)); }
constexpr int RP = 528;
__device__ __forceinline__ bf16x8 tr8(const LAS unsigned char* p0, const LAS unsigned char* p1) {
    const s16x4 v0 = __builtin_amdgcn_ds_read_tr16_b64_v4i16((LAS s16x4*)p0), v1 = __builtin_amdgcn_ds_read_tr16_b64_v4i16((LAS s16x4*)p1);
    return (bf16x8){v0[0], v0[1], v0[2], v0[3], v1[0], v1[1], v1[2], v1[3]};
}
__device__ __forceinline__ void ph_ret_kv(const Args& a, const Ctx& c, int l, int u0, int ustep) {
    const bf16* H = (const bf16*)(a.ws + WS_H); float* KVT = (float*)(a.ws + WS_KVP);
    const float* rsl = (const float*)(a.ws + WS_RSC) + (size_t)l * MTOK; const float* csl = (const float*)(a.ws + WS_RSC) + DEPTH * MTOK + l * NP;
    LAS unsigned char* Kt = c.lds; LAS unsigned char* Vt = c.lds + 128 * RP;
    const int lane = c.lane, w = c.wave, tl = lane & 15, lg = lane >> 4, qq = (lane & 15) >> 2, pp = lane & 3;
    for (int u = u0; u < 1024; u += ustep) {
        const int b = u >> 9, h = (u >> 6) & 7, ck = u & 63, tok0 = b * SEQ + ck * 128;
        const float lgg = ret_logg(h);
#pragma unroll
        for (int i = 0; i < 8; ++i) { const int id = c.tid + 512 * i, row = id >> 5, ch = id & 31;
            *(LAS v4u*)(Kt + row * RP + ch * 16) = *(const v4u*)(H + (size_t)(tok0 + row) * NP + C_RK + h * 256 + ch * 8);
            const v4u x = *(const v4u*)(H + (size_t)(tok0 + row) * NP + C_RV + h * 256 + ch * 8);
            const float z = expf(lgg * (float)(127 - row)) * (rsl[tok0 + row] * 1024.0f);
            const f32x4 k0 = *(const f32x4*)(csl + C_RV + h * 256 + ch * 8), k1 = *(const f32x4*)(csl + C_RV + h * 256 + ch * 8 + 4);
            v4u o; o.x = pk2(lo16(x.x) * z * k0[0], hi16(x.x) * z * k0[1]); o.y = pk2(lo16(x.y) * z * k0[2], hi16(x.y) * z * k0[3]); o.z = pk2(lo16(x.z) * z * k1[0], hi16(x.z) * z * k1[1]); o.w = pk2(lo16(x.w) * z * k1[2], hi16(x.w) * z * k1[3]);
            *(LAS v4u*)(Vt + row * RP + ch * 16) = o; }
        __syncthreads();
        float* Ku = KVT + ((size_t)u << 16);
#pragma unroll 1
        for (int dh = 0; dh < 2; ++dh) {
            f32x4 acc[2][8];
#pragma unroll
            for (int i = 0; i < 2; ++i)
#pragma unroll
                for (int dt = 0; dt < 8; ++dt) acc[i][dt] = (f32x4){0.f, 0.f, 0.f, 0.f};
#pragma unroll 1
            for (int ks = 0; ks < 4; ++ks) {
                const LAS unsigned char* vb = Vt + (8 * lg + qq) * RP + (32 * w + 4 * pp) * 2 + 32 * ks * RP;
                const LAS unsigned char* kb = Kt + (8 * lg + qq) * RP + (128 * dh + 4 * pp) * 2 + 32 * ks * RP;
                bf16x8 af[2];
#pragma unroll
                for (int i = 0; i < 2; ++i) af[i] = tr8(vb + 32 * i, vb + 32 * i + 4 * RP);
#pragma unroll
                for (int dt = 0; dt < 8; ++dt) { const bf16x8 bfr = tr8(kb + 32 * dt, kb + 32 * dt + 4 * RP);
                    acc[0][dt] = __builtin_amdgcn_mfma_f32_16x16x32_bf16(af[0], bfr, acc[0][dt], 0, 0, 0);
                    acc[1][dt] = __builtin_amdgcn_mfma_f32_16x16x32_bf16(af[1], bfr, acc[1][dt], 0, 0, 0); }
            }
#pragma unroll
            for (int i = 0; i < 2; ++i)
#pragma unroll
                for (int dt = 0; dt < 8; ++dt)
#pragma unroll
                    for (int e = 0; e < 4; ++e) Ku[(32 * w + 16 * i + 4 * lg + e) * 256 + 128 * dh + 16 * dt + tl] = acc[i][dt][e];
        }
        __syncthreads();
    }
}
__device__ __forceinline__ void ph_ret_scan(const Args& a, const Ctx& c, int b0, int nb) {
    const float* KVT = (const float*)(a.ws + WS_KVP); bf16* RT = (bf16*)(a.ws + WS_RST);
    const int gt = b0 * (NWAVES * 64) + c.tid, NGT = nb * NWAVES * 64;
    for (int i = gt; i < 16 * 16384; i += NGT) {
        const int bh = i >> 14, q4 = i & 16383, h = bh & 7;
        const float cd = expf(ret_logg(h) * 128.0f);
        f32x4 r = {0.f, 0.f, 0.f, 0.f};
        for (int ck0 = 0; ck0 < 64; ck0 += 8) { f32x4 kv[8];
#pragma unroll
            for (int j = 0; j < 8; ++j) kv[j] = *(const f32x4*)(KVT + ((size_t)(bh * 64 + ck0 + j) << 16) + (size_t)q4 * 4);
#pragma unroll
            for (int j = 0; j < 8; ++j) { const size_t o = ((size_t)(bh * 64 + ck0 + j) << 16) + (size_t)q4 * 4;
                *(unsigned long long*)(RT + o) = (unsigned long long)pk2(r[0], r[1]) | ((unsigned long long)pk2(r[2], r[3]) << 32);
                r = r * cd + kv[j]; } }
    }
}
__device__ __forceinline__ void ph_ret_out(const Args& a, const Ctx& c, int l) {
    const bf16* H = (const bf16*)(a.ws + WS_H); const bf16* RT = (const bf16*)(a.ws + WS_RST); bf16* Y = (bf16*)(a.ws + WS_Y);
    const float* rng = a.in[IN_RNG] + l * BW;
    const float* rsl = (const float*)(a.ws + WS_RSC) + (size_t)l * MTOK; const float* csl = (const float*)(a.ws + WS_RSC) + DEPTH * MTOK + l * NP;
    LAS unsigned char* Kt = c.lds; LAS unsigned char* Vt = c.lds + 128 * RP;
    const int lane = c.lane, w = c.wave, tl = lane & 15, lg = lane >> 4, qq = (lane & 15) >> 2, pp = lane & 3;
    for (int u = c.bx; u < 1024; u += c.G) {
        const int b = u >> 9, h = (u >> 6) & 7, ck = u & 63, tok0 = b * SEQ + ck * 128;
        const float lgg = ret_logg(h);
        unsigned wb0 = (unsigned)((c.tid >> 5) * RP + (c.tid & 31) * 16), rb0 = (unsigned)(tl * RP + lg * 16);
        asm volatile("" : "+v"(wb0), "+v"(rb0)); unsigned wb1 = wb0 + 128 * RP, rb1 = rb0 + 128 * RP;
        asm volatile("" : "+v"(wb1), "+v"(rb1));
        {
            const char* Ru = (const char*)(RT + ((size_t)u << 16)); v4u rr[16]; const unsigned to = (unsigned)c.tid * 16u;
#pragma unroll
            for (int i = 0; i < 16; ++i) rr[i] = *(const v4u*)(Ru + i * 8192 + (size_t)to);
#pragma unroll
            for (int i = 0; i < 16; ++i) *(LAS v4u*)(c.lds + (i < 8 ? wb0 : wb1) + (i & 7) * 16 * RP) = rr[i];
        }
        __builtin_amdgcn_sched_barrier(0);
        const int n = 16 * w + tl;
        bf16x8 qf[8];
#pragma unroll
        for (int ks = 0; ks < 8; ++ks) qf[ks] = *(const bf16x8*)(H + (size_t)(tok0 + n) * NP + C_RQ + h * 256 + 32 * ks + 8 * lg);
        v4u kst[8], vst[8];
        { const unsigned ko = (unsigned)(((c.tid >> 5) * NP + (c.tid & 31) * 8) * 2);
#pragma unroll
          for (int i = 0; i < 8; ++i) { const char* kb_ = (const char*)(H + (size_t)(tok0 + 16 * i) * NP + C_RK + h * 256);
            kst[i] = *(const v4u*)(kb_ + (size_t)ko); vst[i] = *(const v4u*)(kb_ + (C_RV - C_RK) * 2 + (size_t)ko); } }
        __syncthreads();
        f32x4 acc[16];
#pragma unroll
        for (int et = 0; et < 16; ++et) { f32x4 s = {0.f, 0.f, 0.f, 0.f};
#pragma unroll
            for (int ks = 0; ks < 8; ++ks) { const bf16x8 rf = *(const LAS bf16x8*)(c.lds + (et < 8 ? rb0 : rb1) + (et & 7) * 16 * RP + 64 * ks); s = __builtin_amdgcn_mfma_f32_16x16x32_bf16(rf, qf[ks], s, 0, 0, 0); }
            acc[et] = s * expf(lgg * (float)(n + 1)); }
        __builtin_amdgcn_sched_barrier(0);
        float vrs[8];
#pragma unroll
        for (int i = 0; i < 8; ++i) vrs[i] = rsl[tok0 + (c.tid >> 5) + 16 * i] * 1024.0f;
        const f32x4 vk0 = *(const f32x4*)(csl + C_RV + h * 256 + (c.tid & 31) * 8), vk1 = *(const f32x4*)(csl + C_RV + h * 256 + (c.tid & 31) * 8 + 4);
        __syncthreads();
#pragma unroll
        for (int i = 0; i < 8; ++i) { *(LAS v4u*)(c.lds + wb0 + i * 16 * RP) = kst[i];
            float xv[8]; unpack8(vst[i], xv); const float rv_ = vrs[i];
#pragma unroll
            for (int e = 0; e < 4; ++e) { xv[e] *= rv_ * vk0[e]; xv[4 + e] *= rv_ * vk1[e]; }
            *(LAS v4u*)(c.lds + wb1 + i * 16 * RP) = pack8(xv); }
        __syncthreads();
        s16x4 P[8];
#pragma unroll
        for (int mt = 0; mt < 8; ++mt) { P[mt] = (s16x4){0, 0, 0, 0};
            if (mt <= w) { f32x4 s = {0.f, 0.f, 0.f, 0.f};
#pragma unroll
                for (int ks = 0; ks < 8; ++ks) { const bf16x8 kf = *(const LAS bf16x8*)(Kt + (16 * mt + tl) * RP + (32 * ks + 8 * lg) * 2); s = __builtin_amdgcn_mfma_f32_16x16x32_bf16(kf, qf[ks], s, 0, 0, 0); }
                float pv[4];
#pragma unroll
                for (int e = 0; e < 4; ++e) { const int m = 16 * mt + 4 * lg + e; pv[e] = (m <= n) ? s[e] * expf(lgg * (float)(n - m)) : 0.f; }
                typedef unsigned u32x2 __attribute__((ext_vector_type(2)));
                const u32x2 pw = {pk2(pv[0], pv[1]), pk2(pv[2], pv[3])}; P[mt] = __builtin_bit_cast(s16x4, pw); } }
#pragma unroll
        for (int mt = 0; mt < 8; ++mt) { if (mt <= w) {
#pragma unroll
            for (int et = 0; et < 16; ++et) { const s16x4 vf = __builtin_amdgcn_ds_read_tr16_b64_v4i16((LAS s16x4*)(Vt + (16 * mt + 4 * lg + qq) * RP + (16 * et + 4 * pp) * 2));
                acc[et] = __builtin_amdgcn_mfma_f32_16x16x16bf16_1k(vf, P[mt], acc[et], 0, 0, 0); } } }
        {
            float s = 0.f;
#pragma unroll
            for (int et = 0; et < 16; ++et) s += (acc[et][0] + acc[et][1]) + (acc[et][2] + acc[et][3]);
            s += shx<16>(s); s += shx<32>(s);
            const float mean = s * (1.0f / 256.0f); float q = 0.f;
#pragma unroll
            for (int et = 0; et < 16; ++et) { acc[et] = acc[et] - mean; q += (acc[et][0] * acc[et][0] + acc[et][1] * acc[et][1]) + (acc[et][2] * acc[et][2] + acc[et][3] * acc[et][3]); }
            q += shx<16>(q); q += shx<32>(q);
            const float rstd = 1.0f / sqrtf(q * (1.0f / 256.0f) + EPS);
            const size_t tok = (size_t)(tok0 + n); const float rsc = rsl[tok] * 1024.0f;
#pragma unroll
            for (int eb = 0; eb < 4; ++eb) {
                f32x4 gnq[4], kcq[4]; unsigned long long rgq[4];
#pragma unroll
                for (int ee = 0; ee < 4; ++ee) { const int col = h * 256 + 16 * (4 * eb + ee) + 4 * lg;
                    gnq[ee] = *(const f32x4*)(rng + col); rgq[ee] = *(const unsigned long long*)(H + tok * NP + C_RG + col); kcq[ee] = *(const f32x4*)(csl + C_RG + col); }
                unsigned olo[4], ohi[4];
#pragma unroll
                for (int ee = 0; ee < 4; ++ee) { const int et = 4 * eb + ee; const f32x4 gn = gnq[ee], kc = kcq[ee];
                    const unsigned rl = (unsigned)rgq[ee], rh = (unsigned)(rgq[ee] >> 32);
                    const float g0 = pg8::act_apply(lo16(rl) * rsc * kc[0], 1), g1 = pg8::act_apply(hi16(rl) * rsc * kc[1], 1), g2 = pg8::act_apply(lo16(rh) * rsc * kc[2], 1), g3 = pg8::act_apply(hi16(rh) * rsc * kc[3], 1);
                    olo[ee] = pk2(acc[et][0] * rstd * gn[0] * g0, acc[et][1] * rstd * gn[1] * g1); ohi[ee] = pk2(acc[et][2] * rstd * gn[2] * g2, acc[et][3] * rstd * gn[3] * g3); }
#pragma unroll
                for (int ep = 0; ep < 2; ++ep) {
                    const v4u w = swap16_pair(olo[2 * ep], ohi[2 * ep], olo[2 * ep + 1], ohi[2 * ep + 1]);
                    *(v4u*)(Y + tok * BW + h * 256 + 16 * (4 * eb + 2 * ep + (lg & 1)) + 4 * (lg & 2)) = w; } }
        }
        __syncthreads();
    }
}

constexpr int IS_TOK = 8320, IS_BUF = 8 * IS_TOK;
__device__ __forceinline__ void ph_idx_scores(const Args& a, const Ctx& c, int l, int rep = 0) {
    const bf16* H = (const bf16*)(a.ws + WS_H); const bf16* IQP = (const bf16*)(a.ws + WS_IQP); float* SC = (float*)(a.ws + WS_SC);
    unsigned* qhead = (unsigned*)(a.ws + WS_CTL) + CW_QIDX + 64 * (l + 2 * rep);
    volatile LAS unsigned* MISC = (volatile LAS unsigned*)(c.lds + MISC_OFF);
    const int lane = c.lane, w = c.wave, j = lane & 31, hh = lane >> 5;
    constexpr int UPB = 544, NBIG = 2 * UPB - 128;
    if (c.tid == 0) MISC[0] = __hip_atomic_fetch_add(qhead, 1u, __ATOMIC_RELAXED, __HIP_MEMORY_SCOPE_AGENT);
    for (;;) {
        __syncthreads();
        const int U = (int)MISC[0];
        __syncthreads();
        if (U >= NBIG + 4 * (2 * UPB - NBIG)) break;
        unsigned unext = 0u;
        if (c.tid == 0) unext = __hip_atomic_fetch_add(qhead, 1u, __ATOMIC_RELAXED, __HIP_MEMORY_SCOPE_AGENT);
        const int UU = U < NBIG ? U : NBIG + ((U - NBIG) >> 2), g0 = U < NBIG ? 0 : 4 * ((U - NBIG) & 3), g1 = U < NBIG ? 16 : g0 + 4;
        const int b = UU / UPB; int r = UU - b * UPB, tc = 0;
        while (r >= (tc >> 2) + 1) { r -= (tc >> 2) + 1; ++tc; }
        const int kb = r, t0 = 128 * tc, k0 = 512 * kb + 64 * w;
        const bool active = k0 <= t0 + 127;
        bf16x8 kf[2][8];
#pragma unroll
        for (int q = 0; q < 2; ++q) { const bf16* kp = H + (size_t)(b * SEQ + k0 + 32 * q + j) * NP + C_IK + 8 * hh;
#pragma unroll
            for (int ks = 0; ks < 8; ++ks) kf[q][ks] = *(const bf16x8*)(kp + 16 * ks); }
#define IS_STAGE(gi_, bufo_) do { const size_t tok_ = (size_t)(b * SEQ + t0 + 8 * (gi_) + w); const char* src_ = (const char*)(IQP + tok_ * 4096) + lane * 16; \
        _Pragma("unroll") for (int p_ = 0; p_ < 8; ++p_) __builtin_amdgcn_global_load_lds((const unsigned*)(src_ + p_ * 1024), (LAS unsigned*)(c.lds + (bufo_) + w * IS_TOK + p_ * 1024), 16, 0, 0); \
        if (lane < 32) ((LAS float*)(c.lds + (bufo_) + w * IS_TOK + 8192))[lane] = bf2f(H[tok_ * NP + C_IW + lane]) * 0.015625f; } while (0)
#define IS_LOADA(dst_, tk_) do { const LAS unsigned char* tb_ = c.lds + bo + (tk_) * IS_TOK; \
        _Pragma("unroll") for (int ks_ = 0; ks_ < 8; ++ks_) dst_[ks_] = *(const LAS bf16x8*)(tb_ + ks_ * 1024 + lane * 16); } while (0)
#define IS_MMA(src_) do { _Pragma("unroll") for (int i_ = 0; i_ < 16; ++i_) { acc0[i_] = 0.f; acc1[i_] = 0.f; } \
        _Pragma("unroll") for (int ks_ = 0; ks_ < 8; ++ks_) { acc0 = __builtin_amdgcn_mfma_f32_32x32x16_bf16(src_[ks_], kf[0][ks_], acc0, 0, 0, 0); acc1 = __builtin_amdgcn_mfma_f32_32x32x16_bf16(src_[ks_], kf[1][ks_], acc1, 0, 0, 0); } } while (0)
#define IS_EPI(tk_) do { const int t_ = t0 + 8 * gi + (tk_); const LAS unsigned char* tb_ = c.lds + bo + (tk_) * IS_TOK; \
        float s0_ = 0.f, s1_ = 0.f; \
        _Pragma("unroll") for (int g_ = 0; g_ < 4; ++g_) { const f32x4 wq_ = *(const LAS f32x4*)(tb_ + 8192 + (8 * g_ + 4 * hh) * 4); \
            _Pragma("unroll") for (int e_ = 0; e_ < 4; ++e_) { s0_ += wq_[e_] * fmaxf(acc0[4 * g_ + e_], 0.f); s1_ += wq_[e_] * fmaxf(acc1[4 * g_ + e_], 0.f); } } \
        float v_ = hh ? s1_ : s0_; const float o_ = hh ? s0_ : s1_; v_ += shx<32>(o_); \
        if (k0 + lane <= t_) SC[(size_t)(b * SEQ + t_) * SEQ + k0 + lane] = v_; } while (0)
#define IS_TOKEN(tk_) do { bf16x8 af_[8]; f32x16 acc0, acc1; IS_LOADA(af_, tk_); __builtin_amdgcn_sched_barrier(0); IS_MMA(af_); IS_EPI(tk_); } while (0)
#define IS_LOADW(dst_, tk_) do { const LAS unsigned char* tb_ = c.lds + bo + (tk_) * IS_TOK; \
        _Pragma("unroll") for (int g_ = 0; g_ < 4; ++g_) dst_[g_] = *(const LAS f32x4*)(tb_ + 8192 + (8 * g_ + 4 * hh) * 4); } while (0)
#define IS_EPIW(tk_, wq_) do { const int t_ = t0 + 8 * gi + (tk_); float s0_ = 0.f, s1_ = 0.f;     \
        _Pragma("unroll") for (int g_ = 0; g_ < 4; ++g_) { \
            _Pragma("unroll") for (int e_ = 0; e_ < 4; ++e_) { s0_ += wq_[g_][e_] * fmaxf(acc0[4 * g_ + e_], 0.f); s1_ += wq_[g_][e_] * fmaxf(acc1[4 * g_ + e_], 0.f); } } \
        float v_ = hh ? s1_ : s0_; const float o_ = hh ? s0_ : s1_; v_ += shx<32>(o_); \
        SC[(size_t)(b * SEQ + t_) * SEQ + k0 + lane] = v_; } while (0)
        IS_STAGE(g0, (g0 & 1) * IS_BUF);
        VM_WAIT(); LDS_WAIT(); __builtin_amdgcn_s_barrier(); asm volatile("" ::: "memory");
        for (int gi = g0; gi < g1; ++gi) {
            const int bo = (gi & 1) * IS_BUF;
            if (gi + 1 < g1) { const int bn = ((gi + 1) & 1) * IS_BUF; IS_STAGE(gi + 1, bn); }
            if (active) {
                if (k0 + 63 <= t0 + 8 * gi) {
                    bf16x8 afA[8], afB[8]; f32x4 wA[4], wB[4]; f32x16 acc0, acc1;
                    IS_LOADA(afA, 0); IS_LOADW(wA, 0);
#pragma unroll
                    for (int tk = 0; tk < 8; ++tk) {
                        __builtin_amdgcn_sched_barrier(0);
                        if (tk & 1) { IS_MMA(afB); __builtin_amdgcn_sched_barrier(0); if (tk < 7) { IS_LOADA(afA, tk + 1); IS_LOADW(wA, tk + 1); } __builtin_amdgcn_sched_barrier(0); IS_EPIW(tk, wB); }
                        else        { IS_MMA(afA); __builtin_amdgcn_sched_barrier(0); if (tk < 7) { IS_LOADA(afB, tk + 1); IS_LOADW(wB, tk + 1); } __builtin_amdgcn_sched_barrier(0); IS_EPIW(tk, wA); }
                    }
                } else {
                    for (int tk = 0; tk < 8; ++tk) { if (k0 <= t0 + 8 * gi + tk) IS_TOKEN(tk); }
                }
            }
            VM_WAIT(); LDS_WAIT(); asm volatile("" ::: "memory"); __builtin_amdgcn_s_barrier(); asm volatile("" ::: "memory");
        }
        if (c.tid == 0) MISC[0] = unext;
#undef IS_STAGE
#undef IS_TOKEN
#undef IS_LOADA
#undef IS_MMA
#undef IS_EPI
#undef IS_LOADW
#undef IS_EPIW
    }
}

__device__ __forceinline__ unsigned fkey(float f) { const unsigned u = __float_as_uint(f); return (u & 0x80000000u) ? ~u : (u | 0x80000000u); }
__device__ __forceinline__ void topk_row(const float* srow, int n, int* sel, LAS unsigned* hist, int lane) {
    unsigned prefix = 0u; int need = 256;
    for (int pass = 0; pass < 3; ++pass) {
        const int shift = pass == 0 ? 21 : (pass == 1 ? 10 : 0), hshift = pass == 0 ? 31 : (pass == 1 ? 21 : 10);
        const unsigned dmask = pass == 2 ? 1023u : 2047u;
#pragma unroll
        for (int k = 0; k < 8; ++k) *(LAS v4u*)(hist + 4 * (lane + 64 * k)) = (v4u){0u, 0u, 0u, 0u};
        LDS_WAIT();
        v4u kn[4];
#pragma unroll
        for (int j = 0; j < 4; ++j) kn[j] = *(const v4u*)(srow + 256 * j + 4 * lane);
        for (int base = 0; base < n; base += 1024) {
            v4u k4[4];
#pragma unroll
            for (int j = 0; j < 4; ++j) k4[j] = kn[j];
            if (base + 1024 < n) {
#pragma unroll
                for (int j = 0; j < 4; ++j) kn[j] = *(const v4u*)(srow + base + 1024 + 256 * j + 4 * lane); }
#pragma unroll
            for (int j = 0; j < 4; ++j)
#pragma unroll
                for (int e = 0; e < 4; ++e) { const unsigned u = k4[j][e]; const unsigned o = (u & 0x80000000u) ? ~u : (u | 0x80000000u);
                    if (base + 256 * j + 4 * lane + e < n && (pass == 0 || (o >> hshift) == prefix)) __hip_atomic_fetch_add(&hist[(o >> shift) & dmask], 1u, __ATOMIC_RELAXED, __HIP_MEMORY_SCOPE_WORKGROUP); }
        }
        LDS_WAIT();
        unsigned s = 0;
#pragma unroll
        for (int k = 0; k < 8; ++k) { const v4u hv = *(const LAS v4u*)(hist + 2044 - 32 * lane - 4 * k); s += hv.x + hv.y + hv.z + hv.w; }
        unsigned incl = s;
#pragma unroll
        for (int o = 1; o < 64; o <<= 1) { const unsigned tt = sh_up(incl, o); if (lane >= o) incl += tt; }
        const unsigned excl = incl - s;
        const bool mine = (excl < (unsigned)need) && (incl >= (unsigned)need);
        int d = 0, nn = 0;
        if (mine) { unsigned run = excl; bool f = false;
            for (int k = 0; k < 32; ++k) { const unsigned cbk = hist[2047 - 32 * lane - k]; if (!f && run + cbk >= (unsigned)need) { d = 2047 - 32 * lane - k; nn = need - (int)run; f = true; } run += cbk; } }
        const unsigned long long bm = __ballot(mine);
        const int src = (int)__ffsll((long long)bm) - 1;
        d = sh_idx(d, src); nn = sh_idx(nn, src);
        prefix = pass == 2 ? ((prefix << 10) | (unsigned)d) : ((prefix << 11) | (unsigned)d); need = nn;
        LDS_WAIT();
    }
    const unsigned tau = prefix; const int r_eq = need, n_gt = 256 - r_eq;
    int cnt_gt = 0, cnt_eq = 0; const unsigned long long lt = (1ull << lane) - 1ull;
    for (int base = 0; base < n; base += 1024) {
        v4u k4[4];
#pragma unroll
        for (int j = 0; j < 4; ++j) k4[j] = *(const v4u*)(srow + base + 256 * j + 4 * lane);
#pragma unroll
        for (int j = 0; j < 4; ++j)
#pragma unroll
            for (int e = 0; e < 4; ++e) { const unsigned u = k4[j][e]; const unsigned o = (u & 0x80000000u) ? ~u : (u | 0x80000000u); const int i = base + 256 * j + 4 * lane + e;
                const bool valid = i < n, gt = valid && o > tau, eq = valid && o == tau;
                const unsigned long long mg = __ballot(gt), me = __ballot(eq);
                if (gt) sel[cnt_gt + __popcll(mg & lt)] = i;
                if (eq) { const int rk = cnt_eq + __popcll(me & lt); if (rk < r_eq) sel[n_gt + rk] = i; }
                cnt_gt += __popcll(mg); cnt_eq += __popcll(me); }
    }
}
__device__ __forceinline__ void topk_row2(const float* srow, int n, int* sel, LAS unsigned* hist, int lane) {
#pragma unroll
    for (int k = 0; k < 8; ++k) *(LAS v4u*)(hist + 4 * (lane + 64 * k)) = (v4u){0u, 0u, 0u, 0u};
    LDS_WAIT();
    {
        v4u kn[4];
#pragma unroll
        for (int j = 0; j < 4; ++j) kn[j] = *(const v4u*)(srow + 256 * j + 4 * lane);
        for (int base = 0; base < n; base += 1024) {
            v4u k4[4];
#pragma unroll
            for (int j = 0; j < 4; ++j) k4[j] = kn[j];
            if (base + 1024 < n) {
#pragma unroll
                for (int j = 0; j < 4; ++j) kn[j] = *(const v4u*)(srow + base + 1024 + 256 * j + 4 * lane); }
#pragma unroll
            for (int j = 0; j < 4; ++j)
#pragma unroll
                for (int e = 0; e < 4; ++e) { const unsigned u = k4[j][e]; const unsigned o = (u & 0x80000000u) ? ~u : (u | 0x80000000u);
                    if (base + 256 * j + 4 * lane + e < n) __hip_atomic_fetch_add(&hist[o >> 21], 1u, __ATOMIC_RELAXED, __HIP_MEMORY_SCOPE_WORKGROUP); }
        }
    }
    LDS_WAIT();
    int D0, need1, cbin;
    {
        unsigned s = 0;
#pragma unroll
        for (int k = 0; k < 8; ++k) { const v4u hv = *(const LAS v4u*)(hist + 2044 - 32 * lane - 4 * k); s += hv.x + hv.y + hv.z + hv.w; }
        unsigned incl = s;
#pragma unroll
        for (int o = 1; o < 64; o <<= 1) { const unsigned tt = sh_up(incl, o); if (lane >= o) incl += tt; }
        const unsigned excl = incl - s;
        const bool mine = (excl < 256u) && (incl >= 256u);
        int d = 0, nn = 0, cb = 0;
        if (mine) { unsigned run = excl; bool f = false;
            for (int k = 0; k < 32; ++k) { const unsigned cbk = hist[2047 - 32 * lane - k]; if (!f && run + cbk >= 256u) { d = 2047 - 32 * lane - k; nn = 256 - (int)run; cb = (int)cbk; f = true; } run += cbk; } }
        const unsigned long long bm = __ballot(mine);
        const int src = (int)__ffsll((long long)bm) - 1;
        D0 = sh_idx(d, src); need1 = sh_idx(nn, src); cbin = sh_idx(cb, src);
    }
    LDS_WAIT();
    if (cbin > 2048) { topk_row(srow, n, sel, hist, lane); return; }
    LAS unsigned* ckey = hist; LAS unsigned short* cidx = (LAS unsigned short*)(hist + 2048); LAS unsigned* h2 = hist + 3072;
    const unsigned long long lt = (1ull << lane) - 1ull;
    int cnt_gt = 0, cnt_c = 0;
    {
        v4u kn[4];
#pragma unroll
        for (int j = 0; j < 4; ++j) kn[j] = *(const v4u*)(srow + 256 * j + 4 * lane);
        for (int base = 0; base < n; base += 1024) {
            v4u k4[4];
#pragma unroll
            for (int j = 0; j < 4; ++j) k4[j] = kn[j];
            if (base + 1024 < n) {
#pragma unroll
                for (int j = 0; j < 4; ++j) kn[j] = *(const v4u*)(srow + base + 1024 + 256 * j + 4 * lane); }
#pragma unroll
            for (int j = 0; j < 4; ++j)
#pragma unroll
                for (int e = 0; e < 4; ++e) { const unsigned u = k4[j][e]; const unsigned o = (u & 0x80000000u) ? ~u : (u | 0x80000000u); const int i = base + 256 * j + 4 * lane + e;
                    const bool valid = i < n; const int dg = (int)(o >> 21);
                    const bool gt = valid && dg > D0, eq = valid && dg == D0;
                    const unsigned long long mg = __ballot(gt), me = __ballot(eq);
                    if (gt) sel[cnt_gt + __popcll(mg & lt)] = i;
                    if (eq) { const int pos = cnt_c + __popcll(me & lt); ckey[pos] = o & 0x1fffffu; cidx[pos] = (unsigned short)i; }
                    cnt_gt += __popcll(mg); cnt_c += __popcll(me); }
        }
    }
    LDS_WAIT();
    unsigned prefix = 0u; int need = need1;
    for (int pass = 0; pass < 3; ++pass) {
        const int shift = 14 - 7 * pass;
        h2[lane] = 0u; h2[lane + 64] = 0u;
        LDS_WAIT();
        for (int i = lane; i < cnt_c; i += 64) { const unsigned o = ckey[i];
            if (pass == 0 || (o >> (shift + 7)) == prefix) __hip_atomic_fetch_add(&h2[(o >> shift) & 127u], 1u, __ATOMIC_RELAXED, __HIP_MEMORY_SCOPE_WORKGROUP); }
        LDS_WAIT();
        const unsigned c0 = h2[127 - 2 * lane], c1 = h2[126 - 2 * lane], s = c0 + c1;
        unsigned incl = s;
#pragma unroll
        for (int o = 1; o < 64; o <<= 1) { const unsigned tt = sh_up(incl, o); if (lane >= o) incl += tt; }
        const unsigned excl = incl - s;
        const bool mine = (excl < (unsigned)need) && (incl >= (unsigned)need);
        int d = 0, nn = 0;
        if (mine) { if (excl + c0 >= (unsigned)need) { d = 127 - 2 * lane; nn = need - (int)excl; } else { d = 126 - 2 * lane; nn = need - (int)(excl + c0); } }
        const unsigned long long bm = __ballot(mine);
        const int src = (int)__ffsll((long long)bm) - 1;
        d = sh_idx(d, src); nn = sh_idx(nn, src);
        prefix = (prefix << 7) | (unsigned)d; need = nn;
        LDS_WAIT();
    }
    {
        const unsigned tau = prefix; const int r_eq = need, n_gt2 = need1 - r_eq, o0 = 256 - need1;
        int c_gt = 0, c_eq = 0;
        for (int base = 0; base < cnt_c; base += 64) { const int i = base + lane; const bool valid = i < cnt_c;
            const unsigned o = valid ? ckey[i] : 0u; const int id = valid ? (int)cidx[i] : 0;
            const bool gt = valid && o > tau, eq = valid && o == tau;
            const unsigned long long mg = __ballot(gt), me = __ballot(eq);
            if (gt) sel[o0 + c_gt + __popcll(mg & lt)] = id;
            if (eq) { const int rk = c_eq + __popcll(me & lt); if (rk < r_eq) sel[o0 + n_gt2 + rk] = id; }
            c_gt += __popcll(mg); c_eq += __popcll(me); }
    }
    LDS_WAIT();
}
__device__ __forceinline__ void ph_topk(const Args& a, const Ctx& c, int l) {
    const float* SC = (const float*)(a.ws + WS_SC); int* SEL = (int*)(a.ws + WS_SEL);
    LAS unsigned* hist = (LAS unsigned*)(c.lds + c.wave * 16384);
    const int lane = c.lane;
    if ((c.G & 7) == 0) {
        unsigned* ctr = (unsigned*)(a.ws + WS_CTL) + CW_TK + (l * 8 + (c.bx & 7)) * 16;
        unsigned q = 0u;
        if (lane == 0) q = __hip_atomic_fetch_add(ctr, 1u, __ATOMIC_RELAXED, __HIP_MEMORY_SCOPE_AGENT);
        q = (unsigned)__builtin_amdgcn_readfirstlane((int)q);
        while (q < 2048u) {
            unsigned qn = 0u;
            if (lane == 0) qn = __hip_atomic_fetch_add(ctr, 1u, __ATOMIC_RELAXED, __HIP_MEMORY_SCOPE_AGENT);
            const int o = (int)q * 8 + (c.bx & 7), t = SEQ - 1 - (o >> 1), row = (o & 1) * SEQ + t, n = t + 1;
            int* sel = SEL + (size_t)row * 256;
            if (n <= 256) { for (int k = lane; k < 256; k += 64) sel[k] = k < n ? k : -1; }
            else topk_row2(SC + (size_t)row * SEQ, n, sel, hist, lane);
            q = (unsigned)__builtin_amdgcn_readfirstlane((int)qn);
        }
        return;
    }
    const int gw = c.bx * NWAVES + c.wave, NGW = c.G * NWAVES;
    for (int it = gw; it < MTOK; it += NGW) {
        const int u = it & (SEQ - 1), blk = u >> 11, t = (blk & 1) ? (blk << 11) + (2047 - (u & 2047)) : u, row = (it & ~(SEQ - 1)) + t, n = t + 1;
        int* sel = SEL + (size_t)row * 256;
        if (n <= 256) { for (int k = lane; k < 256; k += 64) sel[k] = k < n ? k : -1; }
        else topk_row2(SC + (size_t)row * SEQ, n, sel, hist, lane);
    }
}

__device__ __forceinline__ void ph_dsa_attn(const Args& a, const Ctx& c, int l) {
    const bf16* H = (const bf16*)(a.ws + WS_H); const int* SEL = (const int*)(a.ws + WS_SEL); bf16* Y = (bf16*)(a.ws + WS_Y) + (size_t)MTOK * BW;
    const float* rsl = (const float*)(a.ws + WS_RSC) + (size_t)l * MTOK; const float* csl = (const float*)(a.ws + WS_RSC) + DEPTH * MTOK + l * NP;
    LAS unsigned char* buf = c.lds + c.wave * 18432;
    const int gw = c.bx * NWAVES + c.wave, NGW = c.G * NWAVES, lane = c.lane, cc = lane & 15, g = lane >> 4, jm = cc >> 2;
    int seln[4]; v4u qn[4];
    if (gw < MTOK) {
#pragma unroll
        for (int i = 0; i < 4; ++i) seln[i] = SEL[(size_t)gw * 256 + lane + 64 * i];
#pragma unroll
        for (int ks = 0; ks < 4; ++ks) qn[ks] = *(const v4u*)(H + (size_t)gw * NP + C_DQ + cc * 128 + 32 * ks + 8 * g); }
    for (int row = gw; row < MTOK; row += NGW) {
        const int b = row >> 13, n = (row & (SEQ - 1)) + 1;
        unsigned seli[4];
#pragma unroll
        for (int i = 0; i < 4; ++i) seli[i] = (unsigned)(seln[i] < 0 ? 0 : seln[i]);
        const bf16* hq = H + (size_t)row * NP;
        long qf8[4];
#pragma unroll
        for (int ks = 0; ks < 4; ++ks) { float qv[8]; unpack8(qn[ks], qv); qf8[ks] = (long)pack8_fp8(qv); }
        const char* k8b = (const char*)(a.ws + WS_K8) + (size_t)b * SEQ * 512;
        const char* v8b = (const char*)(a.ws + WS_V8) + (size_t)b * SEQ * 512;
#define DSA_KDMA(kt_, bsel_) do { unsigned sv_ = seli[(kt_) >> 2]; asm volatile("" : "+v"(sv_)); \
        _Pragma("unroll") for (int p_ = 0; p_ < 8; ++p_) { const unsigned sa_ = (unsigned)__builtin_amdgcn_readlane((int)sv_, ((kt_) & 3) * 16 + 2 * p_) << 9, sb_ = (unsigned)__builtin_amdgcn_readlane((int)sv_, ((kt_) & 3) * 16 + 2 * p_ + 1) << 9; \
            const unsigned rr_ = 2u * p_ + (unsigned)(lane >> 5), off_ = (lane < 32 ? sa_ : sb_) + ((((unsigned)lane & 31u) ^ rr_) << 4); \
            __builtin_amdgcn_global_load_lds((const unsigned*)(k8b + (size_t)off_), (LAS unsigned*)(buf + (bsel_) * 8192 + p_ * 1024), 16, 0, 0); } } while (0)
        f32x4 S[16];
        DSA_KDMA(0, 0); DSA_KDMA(1, 1);
#pragma unroll
        for (int kt = 0; kt < 16; ++kt) {
            if (kt < 15) asm volatile("s_waitcnt vmcnt(8)" ::: "memory"); else asm volatile("s_waitcnt vmcnt(0)" ::: "memory");
            f32x4 sacc = {0.f, 0.f, 0.f, 0.f};
#pragma unroll
            for (int j = 0; j < 4; ++j) { long A[4]; f32x4 acc = {0.f, 0.f, 0.f, 0.f};
#pragma unroll
                for (int ks = 0; ks < 4; ++ks) A[ks] = *(const LAS long*)(buf + (kt & 1) * 8192 + cc * 512 + ((((unsigned)(8 * j + 2 * ks + (g >> 1))) ^ (unsigned)cc) << 4) + 8 * (g & 1));
#pragma unroll
                for (int ks = 0; ks < 4; ++ks) acc = __builtin_amdgcn_mfma_f32_16x16x32_fp8_fp8(A[ks], qf8[ks], acc, 0, 0, 0);
                sacc = (jm == j) ? acc : sacc; }
            asm volatile("s_waitcnt lgkmcnt(0)" ::: "memory");
            __builtin_amdgcn_sched_barrier(0);
            if (kt + 2 < 16) DSA_KDMA(kt + 2, kt & 1);
            S[kt] = sacc;
            __builtin_amdgcn_sched_barrier(0);
        }
#undef DSA_KDMA
        float mx = -INFINITY;
        int nt = n - 4 * g; asm volatile("" : "+v"(nt));
#pragma unroll
        for (int kt = 0; kt < 16; ++kt)
#pragma unroll
            for (int e = 0; e < 4; ++e) { float v = S[kt][e] * 0.08838834764831845f; if (16 * kt + e >= nt) v = -INFINITY; S[kt][e] = v; mx = fmaxf(mx, v); }
        mx = fmaxf(mx, shx<16>(mx)); mx = fmaxf(mx, shx<32>(mx));
        float sum = 0.f;
#pragma unroll
        for (int kt = 0; kt < 16; ++kt)
#pragma unroll
            for (int e = 0; e < 4; ++e) { const float pv = __expf(S[kt][e] - mx + 5.545177444479562f); S[kt][e] = pv; sum += pv; }
        sum += shx<16>(sum); sum += shx<32>(sum);
        f32x4 O[8];
#pragma unroll
        for (int dt = 0; dt < 8; ++dt) O[dt] = (f32x4){0.f, 0.f, 0.f, 0.f};
        const unsigned li = (unsigned)lane & 15u, tq = li >> 1, rho = 16u * ((unsigned)g >> 1) + 8u * (tq >> 2) + 4u * ((unsigned)g & 1u) + (tq & 3u);
        const unsigned vrd = (unsigned)(c.wave * 18432) + rho * 512u + 8u * (li & 1u) + ((rho & 15u) << 4);
#pragma unroll
        for (int t = 0; t < 8; ++t) {
            unsigned sv = seli[t >> 1]; asm volatile("" : "+v"(sv));
#pragma unroll
            for (int p_ = 0; p_ < 16; ++p_) {
                const int ra = 2 * p_, rb = 2 * p_ + 1, ka = 16 * ((ra >> 3) & 1) + 8 * (ra >> 4) + (ra & 7), kb2 = 16 * ((rb >> 3) & 1) + 8 * (rb >> 4) + (rb & 7);
                const unsigned sa = (unsigned)__builtin_amdgcn_readlane((int)sv, (t & 1) * 32 + ka) << 9, sb = (unsigned)__builtin_amdgcn_readlane((int)sv, (t & 1) * 32 + kb2) << 9;
                const unsigned rr = 2u * p_ + (unsigned)(lane >> 5), off = (lane < 32 ? sa : sb) + ((((unsigned)lane & 31u) ^ (rr & 15u)) << 4);
                __builtin_amdgcn_global_load_lds((const unsigned*)(v8b + (size_t)off), (LAS unsigned*)(buf + p_ * 1024), 16, 0, 0); }
            asm volatile("s_waitcnt vmcnt(0)" ::: "memory");
            int w0 = __builtin_amdgcn_cvt_pk_fp8_f32(S[2 * t][0], S[2 * t][1], 0, false); w0 = __builtin_amdgcn_cvt_pk_fp8_f32(S[2 * t][2], S[2 * t][3], w0, true);
            int w1 = __builtin_amdgcn_cvt_pk_fp8_f32(S[2 * t + 1][0], S[2 * t + 1][1], 0, false); w1 = __builtin_amdgcn_cvt_pk_fp8_f32(S[2 * t + 1][2], S[2 * t + 1][3], w1, true);
            const long pw = (long)((unsigned long long)(unsigned)w0 | ((unsigned long long)(unsigned)w1 << 32));
#pragma unroll
            for (int j = 0; j < 4; ++j) { const long Bj = ((cc >> 2) == j) ? pw : 0L;
                unsigned va = vrd; asm volatile("" : "+v"(va));
#pragma unroll
                for (int dt = 0; dt < 8; ++dt) { typedef int v2i __attribute__((ext_vector_type(2)));
                    const v2i av = __builtin_amdgcn_ds_read_tr8_b64_v2i32((LAS v2i*)(c.lds + (va ^ (unsigned)((8 * (j & 1) + dt) << 4)) + 256 * (j >> 1)));
                    O[dt] = __builtin_amdgcn_mfma_f32_16x16x32_fp8_fp8(__builtin_bit_cast(long, av), Bj, O[dt], 0, 0, 0); }
                __builtin_amdgcn_sched_barrier(0); }
            asm volatile("s_waitcnt lgkmcnt(0)" ::: "memory");
        }
        __builtin_amdgcn_sched_barrier(0);
        const float inv = 1.0f / sum, rsc = rsl[row] * 1024.0f;
        { const int rnx = (row + NGW < MTOK) ? row + NGW : row;
#pragma unroll
          for (int i = 0; i < 4; ++i) seln[i] = SEL[(size_t)rnx * 256 + lane + 64 * i];
#pragma unroll
          for (int ks = 0; ks < 4; ++ks) qn[ks] = *(const v4u*)(H + (size_t)rnx * NP + C_DQ + cc * 128 + 32 * ks + 8 * g); }
        unsigned long long gdq[8]; f32x4 kcq[8];
#pragma unroll
        for (int dt = 0; dt < 8; ++dt) { const int col = cc * 128 + 16 * dt + 4 * g; gdq[dt] = *(const unsigned long long*)(hq + C_DG + col); kcq[dt] = *(const f32x4*)(csl + C_DG + col); }
        unsigned olo[8], ohi[8];
#pragma unroll
        for (int dt = 0; dt < 8; ++dt) {
            const unsigned gl = (unsigned)gdq[dt], gh = (unsigned)(gdq[dt] >> 32); const f32x4 kc = kcq[dt];
            const float g0 = pg8::act_apply(lo16(gl) * rsc * kc[0], 1), g1 = pg8::act_apply(hi16(gl) * rsc * kc[1], 1), g2 = pg8::act_apply(lo16(gh) * rsc * kc[2], 1), g3 = pg8::act_apply(hi16(gh) * rsc * kc[3], 1);
            olo[dt] = pk2(O[dt][0] * inv * g0, O[dt][1] * inv * g1); ohi[dt] = pk2(O[dt][2] * inv * g2, O[dt][3] * inv * g3); }
#pragma unroll
        for (int dp = 0; dp < 4; ++dp) {
            const v4u w = swap16_pair(olo[2 * dp], ohi[2 * dp], olo[2 * dp + 1], ohi[2 * dp + 1]);
            *(v4u*)(Y + (size_t)row * BW + cc * 128 + 16 * (2 * dp + (g & 1)) + 4 * (g & 2)) = w; }
    }
}

__device__ __forceinline__ void ph_gmlp(const Args& a, const Ctx& c, int l, int u0, int ustep) {
    const bf16* H = (const bf16*)(a.ws + WS_H); const float* GVS = (const float*)(a.ws + WS_GVS); bf16* Y = (bf16*)(a.ws + WS_Y) + (size_t)2 * MTOK * BW;
    const float* gmg = a.in[IN_GMG] + l * BW; const bf16* WSB = (const bf16*)(a.ws + WS_WSB) + (size_t)l * 16 * 128 * 128; const float* bsp = a.in[IN_BS] + l * 16 * 128;
    const float* rsl = (const float*)(a.ws + WS_RSC) + (size_t)l * MTOK; const float* csl = (const float*)(a.ws + WS_RSC) + DEPTH * MTOK + l * NP;
    constexpr int GP = 272;
    const int lane = c.lane, w = c.wave, tl = lane & 15, lg = lane >> 4, qq = (lane & 15) >> 2, pp = lane & 3;
    for (int u = u0; u < 2048; u += ustep) {
        const int b = u >> 10, nck = (u >> 4) & 63, g = u & 15, tok0 = b * SEQ + nck * 128;
#pragma unroll
        for (int i = 0; i < 4; ++i) { const int id = c.tid + 512 * i, s = id >> 4, ch = id & 15; const size_t tok = (size_t)(tok0 + s);
            const v4u x = *(const v4u*)(H + tok * NP + C_GV + g * 128 + 8 * ch); const float mean = GVS[2 * tok], rstd = GVS[2 * tok + 1];
            const f32x4 g0 = *(const f32x4*)(gmg + g * 128 + 8 * ch), g1 = *(const f32x4*)(gmg + g * 128 + 8 * ch + 4);
            v4u o; o.x = pk2((lo16(x.x) - mean) * rstd * g0[0], (hi16(x.x) - mean) * rstd * g0[1]); o.y = pk2((lo16(x.y) - mean) * rstd * g0[2], (hi16(x.y) - mean) * rstd * g0[3]);
            o.z = pk2((lo16(x.z) - mean) * rstd * g1[0], (hi16(x.z) - mean) * rstd * g1[1]); o.w = pk2((lo16(x.w) - mean) * rstd * g1[2], (hi16(x.w) - mean) * rstd * g1[3]);
            *(LAS v4u*)(c.lds + s * GP + ch * 16) = o; }
        bf16x8 wfq[4];
#pragma unroll
        for (int ks = 0; ks < 4; ++ks) wfq[ks] = *(const bf16x8*)(WSB + (size_t)(g * 128 + 16 * w + tl) * 128 + 32 * ks + 8 * lg);
        __syncthreads();
        f32x4 acc[8];
#pragma unroll
        for (int ct = 0; ct < 8; ++ct) acc[ct] = (f32x4){0.f, 0.f, 0.f, 0.f};
        const int nks = (w >> 1) + 1;
#pragma unroll
        for (int ks = 0; ks < 4; ++ks) { if (ks < nks) {
            const bf16x8 wf = wfq[ks];
#pragma unroll
            for (int ct = 0; ct < 8; ++ct) {
                const s16x4 v0 = __builtin_amdgcn_ds_read_tr16_b64_v4i16((LAS s16x4*)(c.lds + (32 * ks + 8 * lg + qq) * GP + (16 * ct + 4 * pp) * 2));
                const s16x4 v1 = __builtin_amdgcn_ds_read_tr16_b64_v4i16((LAS s16x4*)(c.lds + (32 * ks + 8 * lg + 4 + qq) * GP + (16 * ct + 4 * pp) * 2));
                const bf16x8 vf = {v0[0], v0[1], v0[2], v0[3], v1[0], v1[1], v1[2], v1[3]};
                acc[ct] = __builtin_amdgcn_mfma_f32_16x16x32_bf16(vf, wf, acc[ct], 0, 0, 0); }
        } }
        {
            const int t = 16 * w + tl; const size_t tok = (size_t)(tok0 + t); const float bias = bsp[g * 128 + t], rsc = rsl[tok] * 1024.0f;
            unsigned long long guq[8], ggq[8]; f32x4 kuq[8], kgq[8];
#pragma unroll
            for (int ct = 0; ct < 8; ++ct) { const int col = g * 128 + 16 * ct + 4 * lg;
                guq[ct] = *(const unsigned long long*)(H + tok * NP + C_GU + col); ggq[ct] = *(const unsigned long long*)(H + tok * NP + C_GG + col);
                kuq[ct] = *(const f32x4*)(csl + C_GU + col); kgq[ct] = *(const f32x4*)(csl + C_GG + col); }
            unsigned olo[8], ohi[8];
#pragma unroll
            for (int ct = 0; ct < 8; ++ct) {
                const unsigned long long gu = guq[ct], gg = ggq[ct];
                const unsigned ul = (unsigned)gu, uh = (unsigned)(gu >> 32), gl = (unsigned)gg, gh = (unsigned)(gg >> 32);
                const f32x4 ku = kuq[ct], kg = kgq[ct];
                const float u0 = pg8::act_apply(lo16(ul) * rsc * ku[0], 2), u1 = pg8::act_apply(hi16(ul) * rsc * ku[1], 2), u2 = pg8::act_apply(lo16(uh) * rsc * ku[2], 2), u3 = pg8::act_apply(hi16(uh) * rsc * ku[3], 2);
                const float g0 = pg8::act_apply(lo16(gl) * rsc * kg[0], 1), g1 = pg8::act_apply(hi16(gl) * rsc * kg[1], 1), g2 = pg8::act_apply(lo16(gh) * rsc * kg[2], 1), g3 = pg8::act_apply(hi16(gh) * rsc * kg[3], 1);
                olo[ct] = pk2(u0 * (acc[ct][0] + bias) * g0, u1 * (acc[ct][1] + bias) * g1); ohi[ct] = pk2(u2 * (acc[ct][2] + bias) * g2, u3 * (acc[ct][3] + bias) * g3); }
#pragma unroll
            for (int cp = 0; cp < 4; ++cp) {
                const v4u w = swap16_pair(olo[2 * cp], ohi[2 * cp], olo[2 * cp + 1], ohi[2 * cp + 1]);
                *(v4u*)(Y + tok * BW + g * 128 + 16 * (2 * cp + (lg & 1)) + 4 * (lg & 2)) = w; }
        }
        __syncthreads();
    }
}

#ifndef G1_ORDER
#define G1_ORDER StaticOrder
#endif
#ifndef G1_ALIGN
#define G1_ALIGN true
#endif
#ifndef G1_SP2
#define G1_SP2 true
#endif
#ifndef REPM
#define REPM 0
#endif
#define NREP(bit) ((REPM & (bit)) ? 2 : 1)
#ifndef PHM
#define PHM 0xffff
#endif
__global__ void __launch_bounds__(NWAVES * 64, 2) mk_fwd(Args args) {
    extern __shared__ __attribute__((aligned(16))) unsigned char lds_raw[];
    Ctx c; c.lds = (LAS unsigned char*)lds_raw; c.tid = threadIdx.x; c.lane = c.tid & 63; c.wave = __builtin_amdgcn_readfirstlane(c.tid >> 6); c.G = gridDim.x; c.bx = blockIdx.x;
#define FRESH() do { int t_ = threadIdx.x; asm volatile("" : "+v"(t_)); c.tid = t_; c.lane = t_ & 63; c.wave = __builtin_amdgcn_readfirstlane(t_ >> 6); } while (0)
    volatile LAS unsigned* MISC = (volatile LAS unsigned*)(c.lds + MISC_OFF);
    if (c.tid < 64) MISC[c.tid] = 0u;
    __syncthreads();
    unsigned* ctl = (unsigned*)(args.ws + WS_CTL);
#if MK_PER_PHASE
    XcdBarrier bar; bar.bar = ctl + CW_BAR; bar.x = 0; bar.st = nullptr;
#define GRID_BAR() do { } while (0)
#else
    XcdBarrier bar = xcd_barrier_post(ctl + CW_BAR, MISC + 8);
#define GRID_BAR() xcd_barrier(bar)
#endif
    const int lo = args.ph_lo, hi = args.ph_hi;
#define IN(k) (lo <= (k) && (k) < hi)
#define SEAM(k) do { if (IN(k) && IN((k) + 1)) GRID_BAR(); } while (0)
    bf16* const H = (bf16*)(args.ws + WS_H);
    if (IN(0)) { if (PHM & 1) for (int rep = 0; rep < NREP(1); ++rep) { FRESH(); ph_prologue(args, c); } if (PHM & 2) { FRESH(); ph_norm(args, c, 0); } } SEAM(0);
    for (int l = 0; l < DEPTH; ++l) {
        const int p0 = 1 + 8 * l;
        if (l > 0) { if (IN(p0 + 0)) { if (PHM & 2) for (int rep = 0; rep < NREP(2); ++rep) { FRESH(); ph_norm(args, c, l); } } SEAM(p0 + 0); }
        if (IN(p0 + 1) && (PHM & 4)) for (int rep = 0; rep < NREP(4); ++rep) {
            pg8::Gemm g{(const bf16*)(args.ws + WS_XQ), (const bf16*)(args.ws + WS_WQ + (size_t)l * WQ_BYTES), MTOK, NP, DM / 2};
            pg8::StaticOrder S; S.init(MTOK, NP, c.G, c.bx); pg8::EpiGate E{H, NP};
            if ((c.G & 7) == 0) S.limit = (S.nwg / c.G) * c.G;
            pg8::gemm_phase<pg8::EpiGate, pg8::StaticOrder, true, true, 1>(c.lds, g, S, E);
        } SEAM(p0 + 1);
        if (IN(p0 + 2)) {
            if ((PHM & 4) && (c.G & 7) == 0) {
                pg8::Gemm g{(const bf16*)(args.ws + WS_XQ), (const bf16*)(args.ws + WS_WQ + (size_t)l * WQ_BYTES), MTOK, NP, DM / 2};
                pg8::OneUnit S1; S1.base.init(MTOK, NP, c.G, c.bx); S1.L = (S1.base.nwg / c.G) * c.G + c.bx; pg8::EpiGate E{H, NP};
                FRESH(); pg8::gemm_phase<pg8::EpiGate, pg8::OneUnit, true, true, 1>(c.lds, g, S1, E);
                __syncthreads();
            }
            if (PHM & 8) { FRESH(); ph_prep(args, c, l); } } SEAM(p0 + 2);
        if (IN(p0 + 3)) {
            const bool split = (c.G & 31) == 0; const bool memrole = !split || ((c.bx >> 3) & 3) == 0;
            const int mu0 = split ? (c.bx & 7) + 8 * (c.bx >> 5) : c.bx, mus = split ? c.G >> 2 : c.G;
            if (memrole) { if (PHM & 16) for (int rep = 0; rep < NREP(16); ++rep) { FRESH(); ph_ret_kv(args, c, l, mu0, mus); } if (PHM & 64) for (int rep = 0; rep < NREP(64); ++rep) { FRESH(); ph_gmlp(args, c, l, mu0, mus); } }
            if (PHM & 32) for (int rep = 0; rep < NREP(32); ++rep) { FRESH(); ph_idx_scores(args, c, l, rep); } } SEAM(p0 + 3);
        if (IN(p0 + 4)) {
            const bool split = (c.G & 31) == 0; const bool memrole = !split || ((c.bx >> 3) & 3) == 0;
            if (memrole) { if (PHM & 128) for (int rep = 0; rep < NREP(128); ++rep) { FRESH(); ph_ret_scan(args, c, split ? (c.bx & 7) + 8 * (c.bx >> 5) : c.bx, split ? c.G >> 2 : c.G); } }
            if (PHM & 256) { FRESH(); ph_topk(args, c, l); } } SEAM(p0 + 4);
        if (IN(p0 + 5)) { if (PHM & 512) for (int rep = 0; rep < NREP(512); ++rep) { FRESH(); ph_ret_out(args, c, l); } if (PHM & 1024) for (int rep = 0; rep < NREP(1024); ++rep) { FRESH(); ph_dsa_attn(args, c, l); } } SEAM(p0 + 5);
        if (IN(p0 + 6) && (PHM & 2048)) for (int rep = 0; rep < NREP(2048); ++rep) {
            const bf16* Y = (const bf16*)(args.ws + WS_Y); const bf16* WB = (const bf16*)(args.ws + WS_WBR + (size_t)l * 3 * WBR_BYTES);
            bf16* MB = (bf16*)(args.ws + WS_MB);
            const float* rsl = (const float*)(args.ws + WS_RSC) + (size_t)l * MTOK; const float* csl = (const float*)(args.ws + WS_RSC) + DEPTH * MTOK + l * NP;
            pg8::StaticOrder S; S.init(MTOK, DM, c.G, c.bx);
            { pg8::Gemm g{Y, WB, MTOK, DM, BW}; pg8::EpiMerge<0> E{H + C_MG, NP, MB, DM, rsl, csl + C_MG}; pg8::gemm_phase<pg8::EpiMerge<0>, pg8::StaticOrder, true, true>(c.lds, g, S, E); }
            { pg8::Gemm g{Y + (size_t)MTOK * BW, WB + (size_t)DM * BW, MTOK, DM, BW}; pg8::EpiMerge<1> E{H + C_MG + DM, NP, MB, DM, rsl, csl + C_MG + DM}; pg8::gemm_phase<pg8::EpiMerge<1>, pg8::StaticOrder, true, true>(c.lds, g, S, E); }
            { pg8::Gemm g{Y + (size_t)2 * MTOK * BW, WB + (size_t)2 * DM * BW, MTOK, DM, BW}; pg8::EpiMerge<2> E{H + C_MG + 2 * DM, NP, MB, DM, rsl, csl + C_MG + 2 * DM}; pg8::gemm_phase<pg8::EpiMerge<2>, pg8::StaticOrder, true, true>(c.lds, g, S, E); }
        } SEAM(p0 + 6);
        if (IN(p0 + 7) && (PHM & 4096)) for (int rep = 0; rep < NREP(4096); ++rep) {
            pg8::Gemm g{(const bf16*)(args.ws + WS_MB), (const bf16*)(args.ws + WS_WOUT + (size_t)l * WOUT_BYTES), MTOK, DM, DM};
            pg8::StaticOrder S; S.init(MTOK, DM, c.G, c.bx);
            pg8::EpiRes E{(l == 0) ? args.in[IN_X] : (const float*)(args.ws + WS_X1), (l == DEPTH - 1) ? args.out : (float*)(args.ws + WS_X1), DM};
            pg8::gemm_phase<pg8::EpiRes, pg8::StaticOrder, true, true>(c.lds, g, S, E);
        } SEAM(p0 + 7);
    }
#undef IN
#undef SEAM
}

extern "C" void kernel_launch(void* const* d_in, const int* in_sizes, int n_in, void* d_out, int out_size, void* d_ws, size_t ws_size, hipStream_t stream) {
    static int grid = 0;
    if (grid == 0) {
        if (n_in != 12 || out_size != MTOK * DM || ws_size < WS_END) { fprintf(stderr, "kernel_launch: unexpected shapes (n_in %d out %d ws %zu need %zu)\n", n_in, out_size, ws_size, (size_t)WS_END); grid = -1; return; }
        int dev = 0, cus = 0, per_cu = 0;
        if (hipGetDevice(&dev) != hipSuccess || hipDeviceGetAttribute(&cus, hipDeviceAttributeMultiprocessorCount, dev) != hipSuccess) { grid = -1; return; }
        if (hipFuncSetAttribute((const void*)mk_fwd, hipFuncAttributeMaxDynamicSharedMemorySize, LDS_BYTES) != hipSuccess) { fprintf(stderr, "kernel_launch: hipFuncSetAttribute failed\n"); grid = -1; return; }
        if (hipOccupancyMaxActiveBlocksPerMultiprocessor(&per_cu, (const void*)mk_fwd, NWAVES * 64, LDS_BYTES) != hipSuccess || per_cu < 1) fprintf(stderr, "kernel_launch: occupancy query reports %d\n", per_cu);
        (void)hipGetLastError();
        grid = cus;
    }
    if (grid < 0) return;
    if (hipMemsetAsync((char*)d_ws + WS_CTL, 0, CTL_ZERO_BYTES, stream) != hipSuccess) { fprintf(stderr, "kernel_launch: memset failed\n"); return; }
    Args a{};
    for (int i = 0; i < 12; ++i) a.in[i] = (const float*)d_in[i];
    a.out = (float*)d_out; a.ws = (unsigned char*)d_ws;
#if MK_PER_PHASE
    for (int p = 0; p < NPHASE; ++p) { a.ph_lo = p; a.ph_hi = p + 1; hipLaunchKernelGGL(mk_fwd, dim3(grid), dim3(NWAVES * 64), LDS_BYTES, stream, a); }
#else
    a.ph_lo = 0; a.ph_hi = NPHASE;
    hipLaunchKernelGGL(mk_fwd, dim3(grid), dim3(NWAVES * 64), LDS_BYTES, stream, a);
#endif
    const hipError_t le = hipPeekAtLastError();
    if (le != hipSuccess) fprintf(stderr, "kernel_launch: launch failed: %s\n", hipGetErrorName(le));
}
```
